# Optimizing an MI355X kernel written in HIP

```python
import math
import jax
import jax.numpy as jnp
from jax import lax
import numpy as np


D_MODEL = 1024
BATCH = 8
SEQ = 2048
DEPTH = 2

GRID_W = 64
CTX_LEN = 256
N_HEADS_TOTAL = 16
HEAD_DIM = D_MODEL // N_HEADS_TOTAL
N_HEADS_A = 4
N_KV_A = 2
N_HEADS_B = 4
DIFF_DIM = HEAD_DIM // 2
N_HEADS_C = 4
N_KV_C = 2
N_HEADS_D = 4
MIX_WIDTH = (N_HEADS_A + N_HEADS_B + N_HEADS_C + N_HEADS_D) * HEAD_DIM
Q_BLOCK = 128
WINDOW = 128
NA_ROWS = 8
NA_COLS = 16
ROPE_BASE = 10000.0
N_EXPERTS = 16
D_EXPERT = 1024
CAPACITY_FACTOR = 2
EPS = 1e-6
NEG_INF = -1e30
PROJ_WIDTHS = (
    N_HEADS_A * HEAD_DIM, N_KV_A * HEAD_DIM, N_KV_A * HEAD_DIM,
    N_HEADS_B * HEAD_DIM, N_HEADS_B * HEAD_DIM, N_HEADS_B * HEAD_DIM,
    N_HEADS_C * HEAD_DIM, N_KV_C * HEAD_DIM, N_KV_C * HEAD_DIM,
    N_HEADS_D * HEAD_DIM, N_HEADS_D * HEAD_DIM, N_HEADS_D * HEAD_DIM,
)
PROJ_DIM = sum(PROJ_WIDTHS)
SPLIT_POINTS = tuple(int(s) for s in np.cumsum(PROJ_WIDTHS)[:-1])

kernel_name = 'hybrid_dit_parallel_heads_ec_moe'


def rms_norm(x, gain):
    xf = x.astype(jnp.float32)
    y = xf * lax.rsqrt(jnp.mean(xf * xf, axis=-1, keepdims=True) + EPS)
    return (y * gain.astype(jnp.float32)).astype(x.dtype)


def modulate(h, shift, scale):
    return h * (1.0 + scale) + shift


def axial_rope_tables(n_tokens, dim, dtype):
    t = jnp.arange(n_tokens, dtype=jnp.int32)
    rows = (t // GRID_W).astype(jnp.float32)
    cols = (t % GRID_W).astype(jnp.float32)
    n_axis = dim // 4
    inv_freq = ROPE_BASE ** (-jnp.arange(n_axis, dtype=jnp.float32) / n_axis)
    ang = jnp.concatenate([rows[:, None] * inv_freq, cols[:, None] * inv_freq], axis=-1)
    return jnp.cos(ang).astype(dtype), jnp.sin(ang).astype(dtype)


def apply_rope(x, cos, sin):
    shape = (cos.shape[0],) + (1,) * (x.ndim - 3) + (cos.shape[1],)
    cos = cos.reshape(shape)
    sin = sin.reshape(shape)
    xr = x.reshape(x.shape[:-1] + (x.shape[-1] // 2, 2))
    x0, x1 = xr[..., 0], xr[..., 1]
    return jnp.stack([x0 * cos - x1 * sin, x0 * sin + x1 * cos], axis=-1).reshape(x.shape)


def gqa_dense(q, k, v):
    s = jnp.einsum('bqkgd,bskd->bkgqs', q, k).astype(jnp.float32) * (HEAD_DIM ** -0.5)
    p = jax.nn.softmax(s, axis=-1).astype(v.dtype)
    o = jnp.einsum('bkgqs,bskd->bqkgd', p, v)
    return o.reshape(o.shape[0], o.shape[1], -1)


def mixer_axial_gqa(q, k, v, qc, kc, vc, q_gain, k_gain, cos, sin, with_ctx):
    B, L, _ = q.shape
    Lc = kc.shape[1]
    G = N_HEADS_A // N_KV_A
    q = apply_rope(rms_norm(q.reshape(B, L, N_KV_A, G, HEAD_DIM), q_gain), cos, sin)
    k = apply_rope(rms_norm(k.reshape(B, L, N_KV_A, HEAD_DIM), k_gain), cos, sin)
    v = v.reshape(B, L, N_KV_A, HEAD_DIM)
    kc = rms_norm(kc.reshape(B, Lc, N_KV_A, HEAD_DIM), k_gain)
    vc = vc.reshape(B, Lc, N_KV_A, HEAD_DIM)
    k_all = jnp.concatenate([kc, k], axis=1)
    v_all = jnp.concatenate([vc, v], axis=1)
    q_blocks = jnp.moveaxis(q.reshape(B, L // Q_BLOCK, Q_BLOCK, N_KV_A, G, HEAD_DIM), 1, 0)
    out = lax.map(lambda qb: gqa_dense(qb, k_all, v_all), q_blocks)
    out = jnp.moveaxis(out, 0, 1).reshape(B, L, N_HEADS_A * HEAD_DIM)
    out_c = None
    if with_ctx:
        qc = rms_norm(qc.reshape(B, Lc, N_KV_A, G, HEAD_DIM), q_gain)
        out_c = gqa_dense(qc, kc, vc)
    return out, out_c


def mixer_differential(q, k, v, qc, kc, vc, lam_q1, lam_k1, lam_q2, lam_k2, subln_gain, lam_init,
                       cos, sin, with_ctx):
    B, L, _ = q.shape
    Lc = kc.shape[1]
    H = N_HEADS_B
    q = apply_rope(q.reshape(B, L, H, 2, DIFF_DIM), cos, sin)
    k = apply_rope(k.reshape(B, L, H, 2, DIFF_DIM), cos, sin)
    v = v.reshape(B, L, H, HEAD_DIM)
    kc = kc.reshape(B, Lc, H, 2, DIFF_DIM)
    vc = vc.reshape(B, Lc, H, HEAD_DIM)
    lam = (jnp.exp(jnp.sum(lam_q1.astype(jnp.float32) * lam_k1.astype(jnp.float32)))
           - jnp.exp(jnp.sum(lam_q2.astype(jnp.float32) * lam_k2.astype(jnp.float32))) + lam_init)

    def diff_attend(qb, kk, vv):
        s = jnp.einsum('bqhcd,bshcd->bhcqs', qb, kk).astype(jnp.float32) * (DIFF_DIM ** -0.5)
        p = jax.nn.softmax(s, axis=-1)
        a = (p[:, :, 0] - lam * p[:, :, 1]).astype(vv.dtype)
        o = jnp.einsum('bhqs,bshd->bqhd', a, vv)
        o = rms_norm(o, subln_gain) * (1.0 - lam_init)
        return o.reshape(o.shape[0], o.shape[1], H * HEAD_DIM)

    k_all = jnp.concatenate([kc, k], axis=1)
    v_all = jnp.concatenate([vc, v], axis=1)
    q_blocks = jnp.moveaxis(q.reshape(B, L // Q_BLOCK, Q_BLOCK, H, 2, DIFF_DIM), 1, 0)
    out = lax.map(lambda qb: diff_attend(qb, k_all, v_all), q_blocks)
    out = jnp.moveaxis(out, 0, 1).reshape(B, L, H * HEAD_DIM)
    out_c = None
    if with_ctx:
        out_c = diff_attend(qc.reshape(B, Lc, H, 2, DIFF_DIM), kc, vc)
    return out, out_c


def mixer_window_sink(q, k, v, qc, kc, vc, sink, cos, sin, with_ctx):
    B, L, _ = q.shape
    Lc = kc.shape[1]
    G = N_HEADS_C // N_KV_C
    nb = L // Q_BLOCK
    scale = HEAD_DIM ** -0.5
    q = apply_rope(q.reshape(B, L, N_KV_C, G, HEAD_DIM), cos, sin)
    k = apply_rope(k.reshape(B, L, N_KV_C, HEAD_DIM), cos, sin)
    v = v.reshape(B, L, N_KV_C, HEAD_DIM)
    kc = kc.reshape(B, Lc, N_KV_C, HEAD_DIM)
    vc = vc.reshape(B, Lc, N_KV_C, HEAD_DIM)
    sink_kg = sink.reshape(N_KV_C, G).astype(jnp.float32)

    def band(t):
        tp = jnp.pad(t, ((0, 0), (Q_BLOCK, Q_BLOCK), (0, 0), (0, 0)))
        tp = tp.reshape(B, nb + 2, Q_BLOCK, N_KV_C, HEAD_DIM)
        return jnp.concatenate([tp[:, :-2], tp[:, 1:-1], tp[:, 2:]], axis=2)

    kb, vb = band(k), band(v)
    qb = q.reshape(B, nb, Q_BLOCK, N_KV_C, G, HEAD_DIM)
    s_band = jnp.einsum('bnqkgd,bnskd->bnkgqs', qb, kb).astype(jnp.float32) * scale
    s_ctx = jnp.einsum('bnqkgd,bskd->bnkgqs', qb, kc).astype(jnp.float32) * scale
    blk = jnp.arange(nb)[:, None, None] * Q_BLOCK
    qpos = blk + jnp.arange(Q_BLOCK)[None, :, None]
    kpos = blk - Q_BLOCK + jnp.arange(3 * Q_BLOCK)[None, None, :]
    valid = (jnp.abs(kpos - qpos) <= WINDOW) & (kpos >= 0) & (kpos < L)
    s_band = jnp.where(valid[None, :, None, None], s_band, NEG_INF)
    s_sink = jnp.broadcast_to(sink_kg[None, None, :, :, None, None], s_ctx.shape[:-1] + (1,))
    p = jax.nn.softmax(jnp.concatenate([s_sink, s_ctx, s_band], axis=-1), axis=-1)
    p_ctx = p[..., 1:1 + Lc].astype(v.dtype)
    p_band = p[..., 1 + Lc:].astype(v.dtype)
    o = (jnp.einsum('bnkgqs,bskd->bnqkgd', p_ctx, vc)
         + jnp.einsum('bnkgqs,bnskd->bnqkgd', p_band, vb))
    out = o.reshape(B, L, N_HEADS_C * HEAD_DIM)
    out_c = None
    if with_ctx:
        qcg = qc.reshape(B, Lc, N_KV_C, G, HEAD_DIM)
        s = jnp.einsum('bqkgd,bskd->bkgqs', qcg, kc).astype(jnp.float32) * scale
        s_sink_c = jnp.broadcast_to(sink_kg[None, :, :, None, None], s.shape[:-1] + (1,))
        pc = jax.nn.softmax(jnp.concatenate([s_sink_c, s], axis=-1), axis=-1)[..., 1:].astype(v.dtype)
        out_c = jnp.einsum('bkgqs,bskd->bqkgd', pc, vc).reshape(B, Lc, N_HEADS_C * HEAD_DIM)
    return out, out_c


def mixer_neighbourhood(q, k, v, qc, kc, vc, rpb, with_ctx):
    B, L, _ = q.shape
    Lc = kc.shape[1]
    H = N_HEADS_D
    rows = L // GRID_W
    kr = min(NA_ROWS, rows)
    scale = HEAD_DIM ** -0.5
    qg = q.reshape(B, rows, GRID_W, H, HEAD_DIM)
    kg = k.reshape(B, rows, GRID_W, H, HEAD_DIM)
    vg = v.reshape(B, rows, GRID_W, H, HEAD_DIM)
    kc = kc.reshape(B, Lc, H, HEAD_DIM)
    vc = vc.reshape(B, Lc, H, HEAD_DIM)
    r = jnp.arange(rows)
    row_start = jnp.clip(r - kr // 2, 0, rows - kr)
    row_idx = row_start[:, None] + jnp.arange(kr)[None, :]
    k_strip = kg[:, row_idx]
    v_strip = vg[:, row_idx]
    cq = jnp.arange(GRID_W)
    col_start = jnp.clip(cq - NA_COLS // 2, 0, GRID_W - NA_COLS)
    col_valid = (cq[None, :] >= col_start[:, None]) & (cq[None, :] < col_start[:, None] + NA_COLS)
    ri = row_idx - r[:, None] + NA_ROWS - 1
    ci = jnp.clip(cq[None, :] - cq[:, None] + NA_COLS - 1, 0, 2 * NA_COLS - 2)
    bias = rpb[:, ri[:, None, :, None], ci[None, :, None, :]]
    bias = jnp.moveaxis(bias, 0, 1).astype(jnp.float32)
    s = jnp.einsum('brqhd,brkwhd->brhqkw', qg, k_strip).astype(jnp.float32) * scale + bias[None]
    s = jnp.where(col_valid[:, None, :], s, NEG_INF)
    s = s.reshape(B, rows, H, GRID_W, kr * GRID_W)
    s_ctx = jnp.einsum('brqhd,bshd->brhqs', qg, kc).astype(jnp.float32) * scale
    p = jax.nn.softmax(jnp.concatenate([s_ctx, s], axis=-1), axis=-1)
    p_ctx = p[..., :Lc].astype(v.dtype)
    p_nb = p[..., Lc:].reshape(B, rows, H, GRID_W, kr, GRID_W).astype(v.dtype)
    o = (jnp.einsum('brhqkw,brkwhd->brqhd', p_nb, v_strip)
         + jnp.einsum('brhqs,bshd->brqhd', p_ctx, vc))
    out = o.reshape(B, L, H * HEAD_DIM)
    out_c = None
    if with_ctx:
        qcg = qc.reshape(B, Lc, H, HEAD_DIM)
        sc = jnp.einsum('bqhd,bshd->bhqs', qcg, kc).astype(jnp.float32) * scale
        pc = jax.nn.softmax(sc, axis=-1).astype(v.dtype)
        out_c = jnp.einsum('bhqs,bshd->bqhd', pc, vc).reshape(B, Lc, H * HEAD_DIM)
    return out, out_c


def expert_choice_ffn(h, w_router, w_gate, w_up, w_down):
    B, T, D = h.shape
    cap = CAPACITY_FACTOR * T // N_EXPERTS
    aff = jax.nn.softmax(jnp.einsum('btd,de->bte', h, w_router).astype(jnp.float32), axis=-1)
    g, idx = lax.top_k(jnp.swapaxes(aff, 1, 2), cap)
    xe = jax.vmap(lambda hb, ib: hb[ib])(h, idx)
    a = jnp.einsum('becd,edf->becf', xe, w_gate)
    u = jnp.einsum('becd,edf->becf', xe, w_up)
    y = jnp.einsum('becf,efd->becd', jax.nn.silu(a) * u, w_down) * g[..., None].astype(h.dtype)
    return jax.vmap(lambda yb, ib: jnp.zeros((T, D), yb.dtype).at[ib.reshape(-1)].add(yb.reshape(-1, D)))(y, idx)


def setup_inputs(seed: int = 0) -> dict:
    key = jax.random.key(seed)
    ks = jax.random.split(key, 26)
    f32 = jnp.float32
    nrm = lambda k, shape, s: jax.random.normal(k, shape, f32) * s
    return {
        'x': nrm(ks[0], (BATCH, SEQ, D_MODEL), 1.0),
        'c': nrm(ks[1], (BATCH, D_MODEL), 1.0),
        'ctx': nrm(ks[2], (BATCH, CTX_LEN, D_MODEL), 1.0),
        'c_ctx': nrm(ks[3], (D_MODEL,), 1.0),
        'w_ada': nrm(ks[4], (DEPTH, D_MODEL, 6 * D_MODEL), 0.5 * D_MODEL ** -0.5),
        'b_ada': nrm(ks[5], (DEPTH, 6 * D_MODEL), 0.02),
        'g_pre_mix': 1.0 + nrm(ks[6], (DEPTH, D_MODEL), 0.05),
        'g_post_mix': 1.0 + nrm(ks[7], (DEPTH, D_MODEL), 0.05),
        'g_pre_ffn': 1.0 + nrm(ks[8], (DEPTH, D_MODEL), 0.05),
        'g_post_ffn': 1.0 + nrm(ks[9], (DEPTH, D_MODEL), 0.05),
        'w_in': nrm(ks[10], (DEPTH, D_MODEL, PROJ_DIM), D_MODEL ** -0.5),
        'w_out': nrm(ks[11], (DEPTH, MIX_WIDTH, D_MODEL), MIX_WIDTH ** -0.5),
        'q_gain_a': 1.0 + nrm(ks[12], (DEPTH, HEAD_DIM), 0.05),
        'k_gain_a': 1.0 + nrm(ks[13], (DEPTH, HEAD_DIM), 0.05),
        'lam_q1': nrm(ks[14], (DEPTH, DIFF_DIM), 0.1),
        'lam_k1': nrm(ks[15], (DEPTH, DIFF_DIM), 0.1),
        'lam_q2': nrm(ks[16], (DEPTH, DIFF_DIM), 0.1),
        'lam_k2': nrm(ks[17], (DEPTH, DIFF_DIM), 0.1),
        'subln_gain_b': 1.0 + nrm(ks[18], (DEPTH, HEAD_DIM), 0.05),
        'sink_c': nrm(ks[19], (DEPTH, N_HEADS_C), 0.5),
        'rpb_d': nrm(ks[20], (DEPTH, N_HEADS_D, 2 * NA_ROWS - 1, 2 * NA_COLS - 1), 0.5),
        'w_router': nrm(ks[21], (DEPTH, D_MODEL, N_EXPERTS), D_MODEL ** -0.5),
        'w_gate': nrm(ks[22], (DEPTH, N_EXPERTS, D_MODEL, D_EXPERT), D_MODEL ** -0.5),
        'w_up': nrm(ks[23], (DEPTH, N_EXPERTS, D_MODEL, D_EXPERT), D_MODEL ** -0.5),
        'w_down': nrm(ks[24], (DEPTH, N_EXPERTS, D_EXPERT, D_MODEL), D_EXPERT ** -0.5),
    }


def reference(x, c, ctx, c_ctx, w_ada, b_ada, g_pre_mix, g_post_mix, g_pre_ffn, g_post_ffn,
              w_in, w_out, q_gain_a, k_gain_a, lam_q1, lam_k1, lam_q2, lam_k2, subln_gain_b,
              sink_c, rpb_d, w_router, w_gate, w_up, w_down):
    B, L, D = x.shape
    cos_a, sin_a = axial_rope_tables(L, HEAD_DIM, x.dtype)
    cos_b, sin_b = axial_rope_tables(L, DIFF_DIM, x.dtype)
    xc = ctx
    for l in range(DEPTH):
        with_ctx = l < DEPTH - 1
        lam_init = 0.8 - 0.6 * math.exp(-0.3 * l)
        mod = (jax.nn.silu(c) @ w_ada[l] + b_ada[l])[:, None, :]
        mod_c = jax.nn.silu(c_ctx) @ w_ada[l] + b_ada[l]
        sh1, sc1, gt1, sh2, sc2, gt2 = jnp.split(mod, 6, axis=-1)
        sh1c, sc1c, gt1c, sh2c, sc2c, gt2c = jnp.split(mod_c, 6, axis=-1)

        h = modulate(rms_norm(x, g_pre_mix[l]), sh1, sc1)
        hc = modulate(rms_norm(xc, g_pre_mix[l]), sh1c, sc1c)
        p = jnp.split(h @ w_in[l], SPLIT_POINTS, axis=-1)
        pc = jnp.split(hc @ w_in[l], SPLIT_POINTS, axis=-1)
        oa, oa_c = mixer_axial_gqa(p[0], p[1], p[2], pc[0], pc[1], pc[2],
                                   q_gain_a[l], k_gain_a[l], cos_a, sin_a, with_ctx)
        ob, ob_c = mixer_differential(p[3], p[4], p[5], pc[3], pc[4], pc[5],
                                      lam_q1[l], lam_k1[l], lam_q2[l], lam_k2[l], subln_gain_b[l],
                                      lam_init, cos_b, sin_b, with_ctx)
        oc, oc_c = mixer_window_sink(p[6], p[7], p[8], pc[6], pc[7], pc[8],
                                     sink_c[l], cos_a, sin_a, with_ctx)
        od, od_c = mixer_neighbourhood(p[9], p[10], p[11], pc[9], pc[10], pc[11], rpb_d[l], with_ctx)
        o = jnp.concatenate([oa, ob, oc, od], axis=-1) @ w_out[l]
        x = x + gt1 * rms_norm(o, g_post_mix[l])
        if with_ctx:
            o_c = jnp.concatenate([oa_c, ob_c, oc_c, od_c], axis=-1) @ w_out[l]
            xc = xc + gt1c * rms_norm(o_c, g_post_mix[l])

        h = modulate(rms_norm(x, g_pre_ffn[l]), sh2, sc2)
        y = expert_choice_ffn(h, w_router[l], w_gate[l], w_up[l], w_down[l])
        x = x + gt2 * rms_norm(y, g_post_ffn[l])
        if with_ctx:
            hc = modulate(rms_norm(xc, g_pre_ffn[l]), sh2c, sc2c)
            yc = expert_choice_ffn(hc, w_router[l], w_gate[l], w_up[l], w_down[l])
            xc = xc + gt2c * rms_norm(yc, g_post_ffn[l])
    return x
```

```cpp
#include <hip/hip_runtime.h>
#include <cstdio>
#include <cstdint>

#ifndef MK_ONE_LAUNCH
#define MK_ONE_LAUNCH 0
#endif
#ifndef NAIVE_GEMM
#define NAIVE_GEMM 1
#endif
#ifndef NAIVE_ATTN
#define NAIVE_ATTN 1
#endif

#define LAS __attribute__((address_space(3)))
#define GAS __attribute__((address_space(1)))
typedef unsigned short bf16;
typedef unsigned v4u __attribute__((ext_vector_type(4)));
typedef unsigned v2u __attribute__((ext_vector_type(2)));
typedef float f32x4 __attribute__((ext_vector_type(4)));
typedef short bf16x8 __attribute__((ext_vector_type(8)));

constexpr int D = 1024, NB = 8, SEQ = 2048, LC = 256, DEPTH = 2, GRIDW = 64;
constexpr int ML = NB * SEQ, MC = NB * LC, MT = ML + MC;
constexpr int PROJ = 2560, NE = 16, CAP = 256, CAPC = 32, ER = NB * CAP + NB * CAPC;
constexpr float EPS = 1e-6f;
constexpr int NWAVES = 8, NTHR = 512;
__host__ __device__ constexpr int QOFF_(int m) { return m == 0 ? 0 : m == 1 ? 512 : m == 2 ? 1280 : 1792; }
__host__ __device__ constexpr int KOFF_(int m) { return m == 0 ? 256 : m == 1 ? 768 : m == 2 ? 1536 : 2048; }
__host__ __device__ constexpr int VOFF_(int m) { return m == 0 ? 384 : m == 1 ? 1024 : m == 2 ? 1664 : 2304; }

constexpr size_t MiB = 1u << 20;
constexpr size_t WS_CTL = 0, CTL_ZERO_BYTES = 1 * MiB;
constexpr size_t WS_MOD = 1 * MiB;
constexpr size_t WS_ROPE = 2 * MiB;
constexpr size_t WS_AFF = 3 * MiB;
constexpr size_t WS_SLOT = 5 * MiB;
constexpr size_t WS_GATE = 7 * MiB;
constexpr size_t WS_XC = 8 * MiB;
constexpr size_t WS_WIN = 16 * MiB;
constexpr size_t WS_WOUT = 26 * MiB;
constexpr size_t WS_WGU = 32 * MiB;
constexpr size_t WS_WDN = 160 * MiB;
constexpr size_t WS_H = 224 * MiB;
constexpr size_t WS_O = 260 * MiB;
constexpr size_t WS_P = 296 * MiB;
constexpr size_t WS_ACT = 386 * MiB;
constexpr size_t WS_END = 458 * MiB;

constexpr int RING_BYTES = 131072;
constexpr int LDSCTL_OFF = RING_BYTES, MISC_OFF = LDSCTL_OFF + 320;
constexpr int LDS_BYTES = 147456;

#define RLX_AGENT __ATOMIC_RELAXED, __HIP_MEMORY_SCOPE_AGENT
#define LDS_WAIT() asm volatile("s_waitcnt lgkmcnt(0)" ::: "memory")
#define VM_WAIT() asm volatile("s_waitcnt vmcnt(0)" ::: "memory")
__device__ __forceinline__ unsigned f2bf(float f) { unsigned u = __builtin_bit_cast(unsigned, f); return (u + 0x7fffu + ((u >> 16) & 1u)) >> 16; }
__device__ __forceinline__ unsigned pk2(float lo, float hi) { return f2bf(lo) | (f2bf(hi) << 16); }
__device__ __forceinline__ float bflo(unsigned u) { return __builtin_bit_cast(float, u << 16); }
__device__ __forceinline__ float bfhi(unsigned u) { return __builtin_bit_cast(float, u & 0xffff0000u); }
__device__ __forceinline__ float bf2f(bf16 u) { return __builtin_bit_cast(float, (unsigned)u << 16); }
__device__ __forceinline__ float wave_sum(float v) {
#pragma unroll
    for (int o = 1; o < 64; o <<= 1) v += __shfl_xor(v, o);
    return v;
}
__device__ __forceinline__ void ld8(const bf16* p, float* f) {
    const v4u v = *(const v4u*)p;
    f[0] = bflo(v.x); f[1] = bfhi(v.x); f[2] = bflo(v.y); f[3] = bfhi(v.y); f[4] = bflo(v.z); f[5] = bfhi(v.z); f[6] = bflo(v.w); f[7] = bfhi(v.w);
}

#define XB_TMO      128
#define XB_XCNT(j)  (256  + 64 * (j))
#define XB_XSUB(j)  (1280 + 64 * (j))
#define XB_XGEN(j)  (2304 + 64 * (j))
#define XB_TOP      3328
#define XB_TOPGEN   3392
#define XCD_BAR_WORDS 3456
#define XB_SPIN_CAP (1u << 18)
__device__ __forceinline__ unsigned xb_ld(unsigned* p)              { return __hip_atomic_load(p, __ATOMIC_RELAXED, __HIP_MEMORY_SCOPE_AGENT); }
__device__ __forceinline__ unsigned xb_add(unsigned* p, unsigned v) { return __hip_atomic_fetch_add(p, v, __ATOMIC_RELAXED, __HIP_MEMORY_SCOPE_AGENT); }
__device__ __forceinline__ unsigned xb_xcc_id() { return (unsigned)__builtin_amdgcn_s_getreg((3 << 11) | 20) & 0xFu; }
#define XB_SPIN(cond, bar) do { unsigned _sp = 0; while (cond) { __builtin_amdgcn_s_sleep(1); \
    if ((++_sp & 255u) == 0u) { if (xb_ld(&(bar)[XB_TMO])) break; if (_sp > XB_SPIN_CAP) { atomicAdd(&(bar)[XB_TMO], 1u); break; } } } } while (0)
struct XcdBarrier { unsigned* bar; unsigned x; volatile LAS unsigned* st; };
__device__ __forceinline__ XcdBarrier xcd_barrier_post(unsigned* bar, volatile LAS unsigned* st) {
    XcdBarrier b; b.bar = bar; b.x = xb_xcc_id(); b.st = st;
    if (threadIdx.x == 0) (void)xb_add(&bar[XB_XCNT(b.x)], 1u);
    return b;
}
__device__ __forceinline__ void xcd_barrier_complete(unsigned* bar, unsigned x, unsigned& nloc, unsigned& nx) {
    const unsigned G = gridDim.x * gridDim.y * gridDim.z;
    unsigned sum, cnt, mine, sp = 0u;
    for (;;) {
        sum = 0u; cnt = 0u; mine = 0u;
#pragma unroll
        for (unsigned j = 0; j < 16; ++j) { const unsigned c = xb_ld(&bar[XB_XCNT(j)]); sum += c; cnt += (c > 0u) ? 1u : 0u; mine = (j == x) ? c : mine; }
        if (sum == G) break;
        __builtin_amdgcn_s_sleep(1);
        if ((++sp & 255u) == 0u) { if (xb_ld(&bar[XB_TMO])) break; if (sp > XB_SPIN_CAP) { atomicAdd(&bar[XB_TMO], 1u); break; } }
    }
    nloc = mine > 0u ? mine : 1u; nx = cnt > 0u ? cnt : 1u;
}
__device__ __forceinline__ void xcd_barrier(const XcdBarrier& b) {
    asm volatile("s_waitcnt vmcnt(0)" ::: "memory");
    __syncthreads();
    if (threadIdx.x == 0) {
        unsigned* bar = b.bar;
        __builtin_amdgcn_s_waitcnt(0);
        unsigned nloc = b.st[0], nx = b.st[1];
        if (nloc == 0u) { xcd_barrier_complete(bar, b.x, nloc, nx); b.st[0] = nloc; b.st[1] = nx; }
        const unsigned old = xb_add(&bar[XB_XSUB(b.x)], 1u);
        const unsigned gen = old / nloc;
        if (old + 1u == (gen + 1u) * nloc) {
            __builtin_amdgcn_fence(__ATOMIC_RELEASE, "agent");
            asm volatile("s_waitcnt vmcnt(0)" ::: "memory");
            const unsigned og = xb_add(&bar[XB_TOP], 1u);
            const unsigned tg = og / nx;
            if (og + 1u == (tg + 1u) * nx) xb_add(&bar[XB_TOPGEN], 1u);
            else XB_SPIN(xb_ld(&bar[XB_TOPGEN]) == tg, bar);
            __builtin_amdgcn_fence(__ATOMIC_ACQUIRE, "agent");
            xb_add(&bar[XB_XGEN(b.x)], 1u);
            asm volatile("s_waitcnt vmcnt(0)" ::: "memory");
        } else {
            XB_SPIN(xb_ld(&bar[XB_XGEN(b.x)]) == gen, bar);
            __builtin_amdgcn_fence(__ATOMIC_ACQUIRE, "agent");
            asm volatile("s_waitcnt vmcnt(0)" ::: "memory");
        }
    }
    __syncthreads();
}

struct Args { const float* in[25]; float* out; unsigned char* ws; int ph_lo, ph_hi; };
#define CAS __attribute__((address_space(4)))
struct Frame {
    LAS unsigned char* lds;
    int tid, lane, wave, G, bid;
    const CAS Args* ka;
    __device__ __forceinline__ const float* x() const { return ka->in[0]; }
    __device__ __forceinline__ const float* c() const { return ka->in[1]; }
    __device__ __forceinline__ const float* ctx() const { return ka->in[2]; }
    __device__ __forceinline__ const float* c_ctx() const { return ka->in[3]; }
    __device__ __forceinline__ const float* w_ada() const { return ka->in[4]; }
    __device__ __forceinline__ const float* b_ada() const { return ka->in[5]; }
    __device__ __forceinline__ const float* g_pre_mix() const { return ka->in[6]; }
    __device__ __forceinline__ const float* g_post_mix() const { return ka->in[7]; }
    __device__ __forceinline__ const float* g_pre_ffn() const { return ka->in[8]; }
    __device__ __forceinline__ const float* g_post_ffn() const { return ka->in[9]; }
    __device__ __forceinline__ const float* w_in() const { return ka->in[10]; }
    __device__ __forceinline__ const float* w_out() const { return ka->in[11]; }
    __device__ __forceinline__ const float* q_gain_a() const { return ka->in[12]; }
    __device__ __forceinline__ const float* k_gain_a() const { return ka->in[13]; }
    __device__ __forceinline__ const float* lam_q1() const { return ka->in[14]; }
    __device__ __forceinline__ const float* lam_k1() const { return ka->in[15]; }
    __device__ __forceinline__ const float* lam_q2() const { return ka->in[16]; }
    __device__ __forceinline__ const float* lam_k2() const { return ka->in[17]; }
    __device__ __forceinline__ const float* subln() const { return ka->in[18]; }
    __device__ __forceinline__ const float* sink() const { return ka->in[19]; }
    __device__ __forceinline__ const float* rpb() const { return ka->in[20]; }
    __device__ __forceinline__ const float* w_router() const { return ka->in[21]; }
    __device__ __forceinline__ const float* w_gate() const { return ka->in[22]; }
    __device__ __forceinline__ const float* w_up() const { return ka->in[23]; }
    __device__ __forceinline__ const float* w_down() const { return ka->in[24]; }
    __device__ __forceinline__ float* out() const { return ka->out; }
    __device__ __forceinline__ unsigned char* ws() const { return ka->ws; }
    __device__ __forceinline__ float* mod() const { return (float*)(ws() + WS_MOD); }
    __device__ __forceinline__ float* cosA() const { return (float*)(ws() + WS_ROPE); }
    __device__ __forceinline__ float* sinA() const { return cosA() + SEQ * 32; }
    __device__ __forceinline__ float* cosB() const { return cosA() + SEQ * 64; }
    __device__ __forceinline__ float* sinB() const { return cosA() + SEQ * 80; }
    __device__ __forceinline__ float* affT() const { return (float*)(ws() + WS_AFF); }
    __device__ __forceinline__ float* affcT() const { return affT() + NB * NE * SEQ; }
    __device__ __forceinline__ int* slot() const { return (int*)(ws() + WS_SLOT); }
    __device__ __forceinline__ int* slotc() const { return slot() + NB * SEQ * NE; }
    __device__ __forceinline__ float* gate() const { return (float*)(ws() + WS_GATE); }
    __device__ __forceinline__ float* xcw() const { return (float*)(ws() + WS_XC); }
    __device__ __forceinline__ bf16* win_t() const { return (bf16*)(ws() + WS_WIN); }
    __device__ __forceinline__ bf16* wout_t() const { return (bf16*)(ws() + WS_WOUT); }
    __device__ __forceinline__ bf16* wgu_t() const { return (bf16*)(ws() + WS_WGU); }
    __device__ __forceinline__ bf16* wdn_t() const { return (bf16*)(ws() + WS_WDN); }
    __device__ __forceinline__ bf16* h() const { return (bf16*)(ws() + WS_H); }
    __device__ __forceinline__ bf16* o() const { return (bf16*)(ws() + WS_O); }
    __device__ __forceinline__ bf16* p() const { return (bf16*)(ws() + WS_P); }
    __device__ __forceinline__ float* op() const { return (float*)(ws() + WS_P); }
    __device__ __forceinline__ bf16* xe() const { return (bf16*)(ws() + WS_P); }
    __device__ __forceinline__ bf16* Y() const { return (bf16*)(ws() + WS_P); }
    __device__ __forceinline__ bf16* act() const { return (bf16*)(ws() + WS_ACT); }
};

__device__ __forceinline__ void transpose_item(const float* W, int K, int N, bf16* WT, int k0, int n0, int dst_row0, LAS float* scr, int lane) {
#pragma unroll 8
    for (int i = 0; i < 32; ++i) { const int kk = 2 * i + (lane >> 5); scr[kk * 33 + (lane & 31)] = W[(size_t)(k0 + kk) * N + n0 + (lane & 31)]; }
    LDS_WAIT(); asm volatile("" ::: "memory");
    const int c = lane & 7;
#pragma unroll
    for (int j = 0; j < 4; ++j) { const int n = (lane >> 3) + 8 * j; const LAS float* s = scr + (8 * c) * 33 + n;
        v4u o; o.x = pk2(s[0 * 33], s[1 * 33]); o.y = pk2(s[2 * 33], s[3 * 33]); o.z = pk2(s[4 * 33], s[5 * 33]); o.w = pk2(s[6 * 33], s[7 * 33]);
        *(v4u*)(WT + (size_t)(dst_row0 + n) * K + k0 + 8 * c) = o; }
    LDS_WAIT(); asm volatile("" ::: "memory");
}

__device__ __forceinline__ void ph_prologue(Frame& F) {
    {
        LAS float* sl = (LAS float*)F.lds;
        LAS float* red = sl + 9 * 1024;
        for (int i = F.tid; i < 9 * 1024; i += NTHR) { const float v = (i < 8 * 1024) ? F.c()[i] : F.c_ctx()[i - 8 * 1024]; sl[i] = v / (1.f + expf(-v)); }
        __syncthreads();
        for (int it = F.bid; it < 2 * 96; it += F.G) {
            const int l = it / 96, n0 = (it % 96) * 64;
            const float* W = F.w_ada() + (size_t)l * D * 6144 + n0 + F.lane;
            float acc[9];
#pragma unroll
            for (int r = 0; r < 9; ++r) acc[r] = 0.f;
            const int kb = F.wave * 128;
#pragma unroll 8
            for (int k = 0; k < 128; ++k) { const float w = W[(size_t)(kb + k) * 6144];
#pragma unroll
                for (int r = 0; r < 9; ++r) acc[r] = fmaf(sl[r * 1024 + kb + k], w, acc[r]); }
#pragma unroll
            for (int r = 0; r < 9; ++r) red[(F.wave * 9 + r) * 64 + F.lane] = acc[r];
            __syncthreads();
            for (int i = F.tid; i < 9 * 64; i += NTHR) { const int r = i / 64, cl = i % 64; float s = 0.f;
#pragma unroll
                for (int w = 0; w < 8; ++w) s += red[(w * 9 + r) * 64 + cl];
                F.mod()[((size_t)l * 9 + r) * 6144 + n0 + cl] = s + F.b_ada()[l * 6144 + n0 + cl]; }
            __syncthreads();
        }
    }
    __syncthreads();
    {
        LAS float* scr = (LAS float*)(F.lds + F.wave * 16384);
        const int gw = F.bid * NWAVES + F.wave, NGW = F.G * NWAVES;
        constexpr int I_IN = 16 * 80, I_OUT = 16 * 32, I_E = 16 * 32;
        constexpr int N_IN = DEPTH * I_IN, N_OUT = DEPTH * I_OUT, N_EX = DEPTH * NE * 3 * I_E;
        for (int it = gw; it < N_IN + N_OUT + N_EX; it += NGW) {
            int r = it;
            if (r < N_IN) { const int l = r / I_IN, q = r % I_IN, kb = q / 80, nb = q % 80;
                transpose_item(F.w_in() + (size_t)l * D * PROJ, D, PROJ, F.win_t() + (size_t)l * PROJ * D, kb * 64, nb * 32, nb * 32, scr, F.lane); continue; }
            r -= N_IN;
            if (r < N_OUT) { const int l = r / I_OUT, q = r % I_OUT, kb = q / 32, nb = q % 32;
                transpose_item(F.w_out() + (size_t)l * D * D, D, D, F.wout_t() + (size_t)l * D * D, kb * 64, nb * 32, nb * 32, scr, F.lane); continue; }
            r -= N_OUT;
            { const int le = r / (3 * I_E), rem = r % (3 * I_E), which = rem / I_E, q = rem % I_E, kb = q / 32, nb = q % 32, n0 = nb * 32;
              if (which == 2) transpose_item(F.w_down() + (size_t)le * D * D, D, D, F.wdn_t() + (size_t)le * D * D, kb * 64, n0, n0, scr, F.lane);
              else { const int drow = 256 * (n0 / 128) + (n0 % 128) + (which == 1 ? 128 : 0);
                  transpose_item((which == 0 ? F.w_gate() : F.w_up()) + (size_t)le * D * D, D, D, F.wgu_t() + (size_t)le * 2048 * D, kb * 64, n0, drow, scr, F.lane); } }
        }
    }
    {
        const size_t gt = (size_t)F.bid * NTHR + F.tid, NT = (size_t)F.G * NTHR;
        const f32x4* xs = (const f32x4*)F.x(); f32x4* xd = (f32x4*)F.out();
        for (size_t i = gt; i < (size_t)ML * D / 4; i += NT) xd[i] = xs[i];
        const f32x4* cs = (const f32x4*)F.ctx(); f32x4* cd = (f32x4*)F.xcw();
        for (size_t i = gt; i < (size_t)MC * D / 4; i += NT) cd[i] = cs[i];
        for (size_t i = gt; i < (size_t)SEQ * 48; i += NT) {
            const int t = (int)(i / 48), j = (int)(i % 48);
            const double row = (double)(t / GRIDW), col = (double)(t % GRIDW);
            if (j < 32) { const int ia = j & 15; const float inv = (float)pow(10000.0, -(double)ia / 16.0); const float ang = (float)(j < 16 ? row : col) * inv;
                F.cosA()[t * 32 + j] = (float)cos((double)ang); F.sinA()[t * 32 + j] = (float)sin((double)ang); }
            else { const int jb = j - 32, ia = jb & 7; const float inv = (float)pow(10000.0, -(double)ia / 8.0); const float ang = (float)(jb < 8 ? row : col) * inv;
                F.cosB()[t * 16 + jb] = (float)cos((double)ang); F.sinB()[t * 16 + jb] = (float)sin((double)ang); }
        }
    }
}

__device__ __forceinline__ void norm_mod_store(const f32x4 (&v)[4], const float* g, const float* sh, const float* sc, bf16* dst, int lane) {
    float ss = 0.f;
#pragma unroll
    for (int j = 0; j < 4; ++j) ss += (v[j].x * v[j].x + v[j].y * v[j].y) + (v[j].z * v[j].z + v[j].w * v[j].w);
    const float rstd = 1.0f / sqrtf(wave_sum(ss) * (1.f / D) + EPS);
#pragma unroll
    for (int j = 0; j < 4; ++j) { const int c0 = 4 * lane + 256 * j;
        const f32x4 gg = *(const f32x4*)(g + c0), s1 = *(const f32x4*)(sh + c0), s2 = *(const f32x4*)(sc + c0);
        const f32x4 o = (v[j] * rstd * gg) * (1.0f + s2) + s1;
        v2u w; w.x = pk2(o.x, o.y); w.y = pk2(o.z, o.w);
        *(v2u*)(dst + c0) = w; }
}
__device__ __forceinline__ void ph_norm1(Frame& F, int l) {
    const int gw = F.bid * NWAVES + F.wave, NGW = F.G * NWAVES;
    for (int row = gw; row < MT; row += NGW) {
        const float* xr = row < ML ? F.out() + (size_t)row * D : F.xcw() + (size_t)(row - ML) * D;
        const float* md = F.mod() + ((size_t)l * 9 + (row < ML ? row / SEQ : 8)) * 6144;
        f32x4 v[4];
#pragma unroll
        for (int j = 0; j < 4; ++j) v[j] = *(const f32x4*)(xr + 4 * F.lane + 256 * j);
        norm_mod_store(v, F.g_pre_mix() + l * D, md, md + 1024, F.h() + (size_t)row * D, F.lane);
    }
}

struct EpiNBf16 { bf16* C; int ldc;
    __device__ __forceinline__ void operator()(int row, int col, f32x4 lo, f32x4 hi) const {
        v2u a; a.x = pk2(lo.x, lo.y); a.y = pk2(lo.z, lo.w); *(v2u*)(C + (size_t)row * ldc + col) = a;
        v2u b; b.x = pk2(hi.x, hi.y); b.y = pk2(hi.z, hi.w); *(v2u*)(C + (size_t)row * ldc + col + 128) = b; } };
struct EpiNF32 { float* C; int ldc;
    __device__ __forceinline__ void operator()(int row, int col, f32x4 lo, f32x4 hi) const {
        *(f32x4*)(C + (size_t)row * ldc + col) = lo; *(f32x4*)(C + (size_t)row * ldc + col + 128) = hi; } };
__device__ __forceinline__ float silu_f(float a) { return a / (1.f + expf(-a)); }
struct EpiNGateUp { bf16* C;
    __device__ __forceinline__ void operator()(int row, int col, f32x4 lo, f32x4 hi) const {
        const int f = (col >> 8) * 128 + (col & 255);
        v2u a; a.x = pk2(silu_f(lo.x) * hi.x, silu_f(lo.y) * hi.y); a.y = pk2(silu_f(lo.z) * hi.z, silu_f(lo.w) * hi.w);
        *(v2u*)(C + (size_t)row * D + f) = a; } };

template <class Epi>
__device__ __forceinline__ void gemm_naive(Frame& F, const bf16* A, const bf16* Bt, int M, int N, int rows_per_group, size_t b_group_stride, int skip_from, const Epi& epi) {
    constexpr int K = D;
    LAS float* As = (LAS float*)F.lds;
    LAS float* Bs = As + 32 * 132;
    const int nNt = N / 256, nT = (M / 128) * nNt;
    const int ty = F.tid >> 5, tx = F.tid & 31;
    for (int tile = F.bid; tile < nT; tile += F.G) {
        const int mt = tile / nNt, nt = tile % nNt;
        if (rows_per_group && ((mt * 128) % rows_per_group) >= skip_from) continue;
        const bf16* Ab = A + (size_t)mt * 128 * K;
        const bf16* Bb = Bt + (rows_per_group ? (size_t)((mt * 128) / rows_per_group) * b_group_stride : 0) + (size_t)nt * 256 * K;
        float acc[8][8];
#pragma unroll
        for (int i = 0; i < 8; ++i)
#pragma unroll
            for (int j = 0; j < 8; ++j) acc[i][j] = 0.f;
        for (int k0 = 0; k0 < K; k0 += 32) {
            { const int r = F.tid >> 2, kc = (F.tid & 3) * 8; float f[8]; ld8(Ab + (size_t)r * K + k0 + kc, f);
#pragma unroll
              for (int i = 0; i < 8; ++i) As[(kc + i) * 132 + r] = f[i]; }
#pragma unroll
            for (int hh = 0; hh < 2; ++hh) { const int r = (F.tid >> 2) + hh * 128, kc = (F.tid & 3) * 8; float f[8]; ld8(Bb + (size_t)r * K + k0 + kc, f);
#pragma unroll
              for (int i = 0; i < 8; ++i) Bs[(kc + i) * 260 + r] = f[i]; }
            __syncthreads();
#pragma unroll 4
            for (int kk = 0; kk < 32; ++kk) {
                const f32x4 a0 = *(const LAS f32x4*)(As + kk * 132 + ty * 8), a1 = *(const LAS f32x4*)(As + kk * 132 + ty * 8 + 4);
                const f32x4 b0 = *(const LAS f32x4*)(Bs + kk * 260 + tx * 4), b1 = *(const LAS f32x4*)(Bs + kk * 260 + 128 + tx * 4);
                const float a[8] = {a0.x, a0.y, a0.z, a0.w, a1.x, a1.y, a1.z, a1.w};
                const float b[8] = {b0.x, b0.y, b0.z, b0.w, b1.x, b1.y, b1.z, b1.w};
#pragma unroll
                for (int i = 0; i < 8; ++i)
#pragma unroll
                    for (int j = 0; j < 8; ++j) acc[i][j] = fmaf(a[i], b[j], acc[i][j]);
            }
            __syncthreads();
        }
#pragma unroll
        for (int i = 0; i < 8; ++i) epi(mt * 128 + ty * 8 + i, nt * 256 + tx * 4, (f32x4){acc[i][0], acc[i][1], acc[i][2], acc[i][3]}, (f32x4){acc[i][4], acc[i][5], acc[i][6], acc[i][7]});
    }
}

__device__ __forceinline__ void prep_seg(bf16* seg, int width, int lane, bool do_norm, const float* gain, bool do_rope, const float* cs, const float* sn, int dim  ) {
    if (lane * 4 >= width) return;
    const v2u raw = *(const v2u*)(seg + 4 * lane);
    float v[4] = {bflo(raw.x), bfhi(raw.x), bflo(raw.y), bfhi(raw.y)};
    const int d0 = (4 * lane) % dim;
    if (do_norm) {
        float ss = v[0] * v[0] + v[1] * v[1] + v[2] * v[2] + v[3] * v[3];
        ss += __shfl_xor(ss, 1); ss += __shfl_xor(ss, 2); ss += __shfl_xor(ss, 4); ss += __shfl_xor(ss, 8);
        const float rstd = 1.0f / sqrtf(ss * (1.f / 64.f) + EPS);
#pragma unroll
        for (int i = 0; i < 4; ++i) v[i] = v[i] * rstd * gain[d0 + i];
    }
    if (do_rope) {
        const int pi = d0 >> 1;
        const float c0 = cs[pi], s0 = sn[pi], c1 = cs[pi + 1], s1 = sn[pi + 1];
        const float a0 = v[0] * c0 - v[1] * s0, a1 = v[0] * s0 + v[1] * c0, a2 = v[2] * c1 - v[3] * s1, a3 = v[2] * s1 + v[3] * c1;
        v[0] = a0; v[1] = a1; v[2] = a2; v[3] = a3;
    }
    v2u w; w.x = pk2(v[0], v[1]); w.y = pk2(v[2], v[3]);
    *(v2u*)(seg + 4 * lane) = w;
}
__device__ __forceinline__ void ph_prep(Frame& F, int l) {
    const int gw = F.bid * NWAVES + F.wave, NGW = F.G * NWAVES;
    for (int row = gw; row < MT; row += NGW) {
        bf16* pr = F.p() + (size_t)row * PROJ;
        const bool lat = row < ML; const int t = lat ? row % SEQ : 0;
        const float *ca = F.cosA() + t * 32, *sa = F.sinA() + t * 32, *cb = F.cosB() + t * 16, *sb = F.sinB() + t * 16;
        {
            const v2u raw = *(const v2u*)(pr + 4 * F.lane);
            float v[4] = {bflo(raw.x), bfhi(raw.x), bflo(raw.y), bfhi(raw.y)};
            const v2u rawk = *(const v2u*)(pr + 256 + 4 * (F.lane & 31));
            float kx[4] = {bflo(rawk.x), bfhi(rawk.x), bflo(rawk.y), bfhi(rawk.y)};
            float ss = v[0] * v[0] + v[1] * v[1] + v[2] * v[2] + v[3] * v[3];
            float sk = kx[0] * kx[0] + kx[1] * kx[1] + kx[2] * kx[2] + kx[3] * kx[3];
            ss += __shfl_xor(ss, 1); ss += __shfl_xor(ss, 2); ss += __shfl_xor(ss, 4); ss += __shfl_xor(ss, 8);
            sk += __shfl_xor(sk, 1); sk += __shfl_xor(sk, 2); sk += __shfl_xor(sk, 4); sk += __shfl_xor(sk, 8);
            const float rq = 1.0f / sqrtf(ss * (1.f / 64.f) + EPS), rk = 1.0f / sqrtf(sk * (1.f / 64.f) + EPS);
            const int d0 = (4 * F.lane) & 63;
            const float* gq = F.q_gain_a() + l * 64 + d0; const float* gk = F.k_gain_a() + l * 64 + d0;
#pragma unroll
            for (int i = 0; i < 4; ++i) { v[i] = v[i] * rq * gq[i]; kx[i] = kx[i] * rk * gk[i]; }
            if (lat) { const int pi = d0 >> 1; const float c0 = ca[pi], s0 = sa[pi], c1 = ca[pi + 1], s1 = sa[pi + 1];
                float a0 = v[0] * c0 - v[1] * s0, a1 = v[0] * s0 + v[1] * c0, a2 = v[2] * c1 - v[3] * s1, a3 = v[2] * s1 + v[3] * c1;
                v[0] = a0; v[1] = a1; v[2] = a2; v[3] = a3;
                a0 = kx[0] * c0 - kx[1] * s0; a1 = kx[0] * s0 + kx[1] * c0; a2 = kx[2] * c1 - kx[3] * s1; a3 = kx[2] * s1 + kx[3] * c1;
                kx[0] = a0; kx[1] = a1; kx[2] = a2; kx[3] = a3; }
            v2u w; w.x = pk2(v[0], v[1]); w.y = pk2(v[2], v[3]); *(v2u*)(pr + 4 * F.lane) = w;
            if (F.lane < 32) { v2u wk; wk.x = pk2(kx[0], kx[1]); wk.y = pk2(kx[2], kx[3]); *(v2u*)(pr + 256 + 4 * F.lane) = wk; }
        }
        if (lat) {
            prep_seg(pr + 512, 256, F.lane, false, nullptr, true, cb, sb, 32);
            prep_seg(pr + 768, 256, F.lane, false, nullptr, true, cb, sb, 32);
            prep_seg(pr + 1280, 256, F.lane, false, nullptr, true, ca, sa, 64);
            prep_seg(pr + 1536, 128, F.lane, false, nullptr, true, ca, sa, 64);
        }
    }
}

__device__ __forceinline__ void ldrow64(const bf16* p, float* f) {
#pragma unroll
    for (int i = 0; i < 8; ++i) ld8(p + 8 * i, f + 8 * i);
}
template <int MIX>
__device__ __forceinline__ void attn_naive_q(Frame& F, int l, int b, int h, int qi, bool isctx) {
    const bf16* P = F.p();
    const size_t qrow = isctx ? (size_t)(ML + b * LC + qi) : (size_t)(b * SEQ + qi);
    const int kvh = (MIX == 0 || MIX == 2) ? (h >> 1) : h;
    const int qo = QOFF_(MIX) + h * 64, ko = KOFF_(MIX) + kvh * 64, vo = VOFF_(MIX) + kvh * 64;
    float q[64]; ldrow64(P + qrow * PROJ + qo, q);
    float o[64];
#pragma unroll
    for (int d = 0; d < 64; ++d) o[d] = 0.f;
    const size_t crow0 = (size_t)(ML + b * LC), lrow0 = (size_t)b * SEQ;
    if (MIX != 1) {
#pragma unroll
        for (int d = 0; d < 64; ++d) q[d] *= 0.125f;
        float m = -INFINITY, ls = 0.f;
        if (MIX == 2) { m = F.sink()[l * 4 + h]; ls = 1.f; }
        const int r_ = qi / GRIDW, cq_ = qi % GRIDW;
        int rs_ = r_ - 4; rs_ = rs_ < 0 ? 0 : (rs_ > 24 ? 24 : rs_);
        int cs_ = cq_ - 8; cs_ = cs_ < 0 ? 0 : (cs_ > 48 ? 48 : cs_);
        const int nk = LC + (isctx ? 0 : (MIX == 0 ? SEQ : (MIX == 2 ? 257 : 128)));
        for (int j = 0; j < nk; ++j) {
            size_t krow = crow0 + j; float bias = 0.f; bool valid = true;
            if (j >= LC) { const int jj = j - LC;
                if (MIX == 0) krow = lrow0 + jj;
                if (MIX == 2) { const int t2 = qi - 128 + jj; valid = (t2 >= 0 && t2 < SEQ); krow = lrow0 + (valid ? t2 : 0); }
                if (MIX == 3) { const int kr = jj >> 4, w = cs_ + (jj & 15); const int ri = rs_ + kr - r_ + 7; int ci = w - cq_ + 15; ci = ci < 0 ? 0 : (ci > 30 ? 30 : ci);
                    krow = lrow0 + (size_t)(rs_ + kr) * GRIDW + w; bias = F.rpb()[((l * 4 + h) * 15 + ri) * 31 + ci]; } }
            if (valid) {
                float s = 0.f;
#pragma unroll
                for (int c8 = 0; c8 < 8; ++c8) { float kf[8]; ld8(P + krow * PROJ + ko + 8 * c8, kf);
#pragma unroll
                    for (int i = 0; i < 8; ++i) s = fmaf(q[8 * c8 + i], kf[i], s);
                    if (c8 & 1) asm volatile("" ::: "memory"); }
                s += bias;
                const float mn = fmaxf(m, s), cr = expf(m - mn), pe = expf(s - mn);
                ls = ls * cr + pe;
#pragma unroll
                for (int c8 = 0; c8 < 8; ++c8) { float kf[8]; ld8(P + krow * PROJ + vo + 8 * c8, kf);
#pragma unroll
                    for (int i = 0; i < 8; ++i) o[8 * c8 + i] = o[8 * c8 + i] * cr + pe * kf[i];
                    if (c8 & 1) asm volatile("" ::: "memory"); }
                m = mn;
            }
        }
        const float inv = 1.f / ls;
#pragma unroll
        for (int d = 0; d < 64; ++d) o[d] *= inv;
    } else {
        const float sc = 0.17677669529663687f;
#pragma unroll
        for (int d = 0; d < 64; ++d) q[d] *= sc;
        float m1 = -INFINITY, l1 = 0.f, m2 = -INFINITY, l2 = 0.f;
        const int nk = isctx ? LC : LC + SEQ;
        for (int j = 0; j < nk; ++j) { const size_t krow = j < LC ? crow0 + j : lrow0 + (j - LC);
            float s1 = 0.f, s2 = 0.f;
#pragma unroll
            for (int c8 = 0; c8 < 4; ++c8) { float kf[8], kg[8]; ld8(P + krow * PROJ + ko + 8 * c8, kf); ld8(P + krow * PROJ + ko + 32 + 8 * c8, kg);
#pragma unroll
                for (int i = 0; i < 8; ++i) { s1 = fmaf(q[8 * c8 + i], kf[i], s1); s2 = fmaf(q[32 + 8 * c8 + i], kg[i], s2); }
                asm volatile("" ::: "memory"); }
            float mn = fmaxf(m1, s1); l1 = l1 * expf(m1 - mn) + expf(s1 - mn); m1 = mn;
            mn = fmaxf(m2, s2); l2 = l2 * expf(m2 - mn) + expf(s2 - mn); m2 = mn; }
        float d1 = 0.f, d2 = 0.f;
        for (int i = 0; i < 32; ++i) { d1 += F.lam_q1()[l * 32 + i] * F.lam_k1()[l * 32 + i]; d2 += F.lam_q2()[l * 32 + i] * F.lam_k2()[l * 32 + i]; }
        const float lam_init = 0.8f - 0.6f * expf(-0.3f * (float)l);
        const float lam = expf(d1) - expf(d2) + lam_init;
        const float i1 = 1.f / l1, i2 = lam / l2;
        for (int j = 0; j < nk; ++j) { const size_t krow = j < LC ? crow0 + j : lrow0 + (j - LC);
            float s1 = 0.f, s2 = 0.f;
#pragma unroll
            for (int c8 = 0; c8 < 4; ++c8) { float kf[8], kg[8]; ld8(P + krow * PROJ + ko + 8 * c8, kf); ld8(P + krow * PROJ + ko + 32 + 8 * c8, kg);
#pragma unroll
                for (int i = 0; i < 8; ++i) { s1 = fmaf(q[8 * c8 + i], kf[i], s1); s2 = fmaf(q[32 + 8 * c8 + i], kg[i], s2); }
                asm volatile("" ::: "memory"); }
            const float a = expf(s1 - m1) * i1 - expf(s2 - m2) * i2;
#pragma unroll
            for (int c8 = 0; c8 < 8; ++c8) { float kf[8]; ld8(P + krow * PROJ + vo + 8 * c8, kf);
#pragma unroll
                for (int i = 0; i < 8; ++i) o[8 * c8 + i] = fmaf(a, kf[i], o[8 * c8 + i]);
                if (c8 & 1) asm volatile("" ::: "memory"); } }
        float ss = 0.f;
#pragma unroll
        for (int d = 0; d < 64; ++d) ss += o[d] * o[d];
        const float rstd = 1.0f / sqrtf(ss * (1.f / 64.f) + EPS) * (1.f - lam_init);
#pragma unroll
        for (int d = 0; d < 64; ++d) o[d] = o[d] * rstd * F.subln()[l * 64 + d];
    }
    bf16* orow = F.o() + qrow * D + MIX * 256 + h * 64;
#pragma unroll
    for (int d = 0; d < 64; d += 8) { v4u w; w.x = pk2(o[d], o[d + 1]); w.y = pk2(o[d + 2], o[d + 3]); w.z = pk2(o[d + 4], o[d + 5]); w.w = pk2(o[d + 6], o[d + 7]); *(v4u*)(orow + d) = w; }
}
__device__ __forceinline__ void ph_attn_naive(Frame& F, int l) {
    const int nitems = 512 + (l == 0 ? 128 : 0);
    for (int it = F.bid; it < nitems; it += F.G) {
        if (it < 512) { const int mo = it / 128, r = it % 128, b = r / 16, h = (r / 4) % 4, ch = r % 4, qi = ch * 512 + F.tid;
            if (mo == 0) attn_naive_q<1>(F, l, b, h, qi, false); else if (mo == 1) attn_naive_q<0>(F, l, b, h, qi, false);
            else if (mo == 2) attn_naive_q<3>(F, l, b, h, qi, false); else attn_naive_q<2>(F, l, b, h, qi, false); }
        else { const int r = it - 512, mix = r / 32, b = (r / 4) % 8, h = r % 4;
            if (F.tid < LC) { if (mix == 0) attn_naive_q<0>(F, l, b, h, F.tid, true); else if (mix == 1) attn_naive_q<1>(F, l, b, h, F.tid, true);
                else if (mix == 2) attn_naive_q<2>(F, l, b, h, F.tid, true); else attn_naive_q<3>(F, l, b, h, F.tid, true); } }
    }
}

__device__ __forceinline__ void ph_n2(Frame& F, int l) {
    LAS float* wr = (LAS float*)F.lds;
    for (int i = F.tid; i < D * NE; i += NTHR) { const int k = i / NE, e = i % NE; wr[e * D + k] = F.w_router()[(size_t)l * D * NE + i]; }
    __syncthreads();
    const int gw = F.bid * NWAVES + F.wave, NGW = F.G * NWAVES;
    const int nrows = (l == 0) ? MT : ML;
    for (int row = gw; row < nrows; row += NGW) {
        const bool lat = row < ML;
        float* xr = lat ? F.out() + (size_t)row * D : F.xcw() + (size_t)(row - ML) * D;
        const float* md = F.mod() + ((size_t)l * 9 + (lat ? row / SEQ : 8)) * 6144;
        const float* opr = F.op() + (size_t)row * D;
        f32x4 v[4]; float ss = 0.f;
#pragma unroll
        for (int j = 0; j < 4; ++j) { v[j] = *(const f32x4*)(opr + 4 * F.lane + 256 * j); ss += (v[j].x * v[j].x + v[j].y * v[j].y) + (v[j].z * v[j].z + v[j].w * v[j].w); }
        const float rstd = 1.0f / sqrtf(wave_sum(ss) * (1.f / D) + EPS);
#pragma unroll
        for (int j = 0; j < 4; ++j) { const int c0 = 4 * F.lane + 256 * j;
            const f32x4 xo = *(const f32x4*)(xr + c0), gg = *(const f32x4*)(F.g_post_mix() + l * D + c0), gt = *(const f32x4*)(md + 2048 + c0);
            v[j] = xo + gt * (v[j] * rstd * gg);
            *(f32x4*)(xr + c0) = v[j]; }
        float s2 = 0.f;
#pragma unroll
        for (int j = 0; j < 4; ++j) s2 += (v[j].x * v[j].x + v[j].y * v[j].y) + (v[j].z * v[j].z + v[j].w * v[j].w);
        const float rstd2 = 1.0f / sqrtf(wave_sum(s2) * (1.f / D) + EPS);
        float lg[NE];
#pragma unroll
        for (int e = 0; e < NE; ++e) lg[e] = 0.f;
#pragma unroll
        for (int j = 0; j < 4; ++j) { const int c0 = 4 * F.lane + 256 * j;
            const f32x4 gg = *(const f32x4*)(F.g_pre_ffn() + l * D + c0), s1 = *(const f32x4*)(md + 3072 + c0), sc = *(const f32x4*)(md + 4096 + c0);
            const f32x4 hv = (v[j] * rstd2 * gg) * (1.0f + sc) + s1;
            v2u w; w.x = pk2(hv.x, hv.y); w.y = pk2(hv.z, hv.w);
            *(v2u*)(F.h() + (size_t)row * D + c0) = w;
            v[j] = hv; }
#pragma unroll
        for (int e = 0; e < NE; ++e) {
#pragma unroll
            for (int j = 0; j < 4; ++j) { const f32x4 ww = *(const LAS f32x4*)(wr + e * D + 4 * F.lane + 256 * j); lg[e] += (v[j].x * ww.x + v[j].y * ww.y) + (v[j].z * ww.z + v[j].w * ww.w); }
            if ((e & 1) == 1) asm volatile("" ::: "memory"); }
#pragma unroll
        for (int e = 0; e < NE; ++e) lg[e] = wave_sum(lg[e]);
        float mx = lg[0];
#pragma unroll
        for (int e = 1; e < NE; ++e) mx = fmaxf(mx, lg[e]);
        float se = 0.f;
#pragma unroll
        for (int e = 0; e < NE; ++e) { lg[e] = expf(lg[e] - mx); se += lg[e]; }
        float mine = 0.f;
#pragma unroll
        for (int e = 0; e < NE; ++e) mine = (F.lane == e) ? lg[e] : mine;
        if (F.lane < NE) {
            if (lat) F.affT()[((size_t)(row / SEQ) * NE + F.lane) * SEQ + (row % SEQ)] = mine / se;
            else { const int rc = row - ML; F.affcT()[((size_t)(rc / LC) * NE + F.lane) * LC + (rc % LC)] = mine / se; }
        }
    }
}

__device__ __forceinline__ void ph_topk(Frame& F, int l) {
    LAS float* sv = (LAS float*)F.lds;
    LAS int* sidx = (LAS int*)(sv + SEQ);
    const int nitems = 128 + (l == 0 ? 128 : 0);
    for (int it = F.bid; it < nitems; it += F.G) {
        const bool lat = it < 128; const int be = lat ? it : it - 128, b = be / NE, e = be % NE;
        const int n = lat ? SEQ : LC, cap = lat ? CAP : CAPC;
        const float* vals = lat ? F.affT() + (size_t)be * SEQ : F.affcT() + (size_t)be * LC;
        __syncthreads();
        for (int i = F.tid; i < n; i += NTHR) sv[i] = vals[i];
        __syncthreads();
        for (int t0 = F.tid; t0 < n; t0 += NTHR) {
            const float v = sv[t0]; int rank = 0;
            for (int u = 0; u < n; u += 4) { const f32x4 w = *(const LAS f32x4*)(sv + u);
                rank += (w.x > v || (w.x == v && u < t0)) ? 1 : 0; rank += (w.y > v || (w.y == v && u + 1 < t0)) ? 1 : 0;
                rank += (w.z > v || (w.z == v && u + 2 < t0)) ? 1 : 0; rank += (w.w > v || (w.w == v && u + 3 < t0)) ? 1 : 0; }
            const int s = rank < cap ? rank : -1;
            if (lat) F.slot()[((size_t)b * SEQ + t0) * NE + e] = s; else F.slotc()[((size_t)b * LC + t0) * NE + e] = s;
            if (s >= 0) { sidx[s] = t0; F.gate()[(size_t)e * ER + (lat ? b * CAP : NB * CAP + b * CAPC) + s] = v; }
        }
        __syncthreads();
        for (int s = F.wave; s < cap; s += NWAVES) {
            const int t0 = sidx[s];
            const bf16* src = F.h() + (size_t)(lat ? b * SEQ + t0 : ML + b * LC + t0) * D;
            bf16* dst = F.xe() + ((size_t)e * ER + (lat ? b * CAP : NB * CAP + b * CAPC) + s) * D;
            const v4u a0 = *(const v4u*)(src + 8 * F.lane), a1 = *(const v4u*)(src + 512 + 8 * F.lane);
            *(v4u*)(dst + 8 * F.lane) = a0; *(v4u*)(dst + 512 + 8 * F.lane) = a1;
        }
    }
}

__device__ __forceinline__ void ph_n3(Frame& F, int l) {
    const int gw = F.bid * NWAVES + F.wave, NGW = F.G * NWAVES;
    const int nrows = (l == 0) ? MT : ML;
    for (int row = gw; row < nrows; row += NGW) {
        const bool lat = row < ML; const int rc = row - ML;
        float* xr = lat ? F.out() + (size_t)row * D : F.xcw() + (size_t)rc * D;
        const int mrow = lat ? row / SEQ : 8;
        const float* md = F.mod() + ((size_t)l * 9 + mrow) * 6144;
        const int* sp = lat ? F.slot() + (size_t)row * NE : F.slotc() + (size_t)rc * NE;
        const int rbase = lat ? (row / SEQ) * CAP : NB * CAP + (rc / LC) * CAPC;
        const int sl = sp[F.lane & 15];
        f32x4 y[4];
#pragma unroll
        for (int j = 0; j < 4; ++j) y[j] = (f32x4){0.f, 0.f, 0.f, 0.f};
        for (int e = 0; e < NE; ++e) {
            const int s = __shfl(sl, e);
            if (s >= 0) {
                const size_t er = (size_t)e * ER + rbase + s;
                const float g = F.gate()[er];
                const bf16* yr = F.Y() + er * D;
#pragma unroll
                for (int j = 0; j < 4; ++j) { const v2u w = *(const v2u*)(yr + 4 * F.lane + 256 * j);
                    y[j].x += g * bflo(w.x); y[j].y += g * bfhi(w.x); y[j].z += g * bflo(w.y); y[j].w += g * bfhi(w.y); }
            }
        }
        float ss = 0.f;
#pragma unroll
        for (int j = 0; j < 4; ++j) ss += (y[j].x * y[j].x + y[j].y * y[j].y) + (y[j].z * y[j].z + y[j].w * y[j].w);
        const float rstd = 1.0f / sqrtf(wave_sum(ss) * (1.f / D) + EPS);
        f32x4 v[4];
#pragma unroll
        for (int j = 0; j < 4; ++j) { const int c0 = 4 * F.lane + 256 * j;
            const f32x4 xo = *(const f32x4*)(xr + c0), gg = *(const f32x4*)(F.g_post_ffn() + l * D + c0), gt = *(const f32x4*)(md + 5120 + c0);
            v[j] = xo + gt * (y[j] * rstd * gg);
            *(f32x4*)(xr + c0) = v[j]; }
        if (l + 1 < DEPTH) {
            const float* md2 = F.mod() + ((size_t)(l + 1) * 9 + mrow) * 6144;
            norm_mod_store(v, F.g_pre_mix() + (l + 1) * D, md2, md2 + 1024, F.h() + (size_t)row * D, F.lane);
        }
    }
}

constexpr int NPHASE = 2 + 9 * DEPTH;

__global__ void __launch_bounds__(NTHR, 2) fwd_kernel(Args args) {
    extern __shared__ __attribute__((aligned(16))) unsigned char lds[];
    Frame F;
    F.lds = (LAS unsigned char*)lds;
    F.tid = threadIdx.x; F.lane = F.tid & 63; F.wave = __builtin_amdgcn_readfirstlane(F.tid >> 6);
    F.G = gridDim.x; F.bid = blockIdx.x;
    unsigned char* ws = args.ws;
    for (int u = F.tid; u < (LDS_BYTES - LDSCTL_OFF) / 4; u += NTHR) ((LAS unsigned*)(F.lds + LDSCTL_OFF))[u] = 0u;
    __syncthreads();
    volatile LAS unsigned* MISC = (volatile LAS unsigned*)(F.lds + MISC_OFF);
    XcdBarrier bar; bar.bar = (unsigned*)(ws + WS_CTL) + 4096; bar.x = 0; bar.st = nullptr;
    const int lo = args.ph_lo, hi = args.ph_hi;
    if (hi - lo > 1) bar = xcd_barrier_post((unsigned*)(ws + WS_CTL) + 4096, MISC + 8);

#ifndef PHSEL
#define PHSEL(k) true
#endif
    for (int ph = lo; ph < hi; ++ph) {
        { const CAS Args* kp = (const CAS Args*)__builtin_amdgcn_kernarg_segment_ptr(); asm volatile("" : "+s"(kp)); F.ka = kp;
          int t_ = threadIdx.x, b_ = blockIdx.x, g_ = gridDim.x; asm volatile("" : "+v"(t_), "+s"(b_), "+s"(g_));
          F.tid = t_; F.lane = t_ & 63; F.wave = __builtin_amdgcn_readfirstlane(t_ >> 6); F.bid = b_; F.G = g_; }
        if (ph == 0) { if (PHSEL(100)) ph_prologue(F); }
        else if (ph == 1) { if (PHSEL(101)) ph_norm1(F, 0); }
        else {
            const int l = (ph - 2) / 9, s = (ph - 2) % 9;
            if (PHSEL(s)) switch (s) {
            case 0: { EpiNBf16 E{F.p(), PROJ}; gemm_naive(F, F.h(), F.win_t() + (size_t)l * PROJ * D, MT, PROJ, 0, 0, 0, E); } break;
            case 1: ph_prep(F, l); break;
            case 2: ph_attn_naive(F, l); break;
            case 3: { EpiNF32 E{F.op(), D}; gemm_naive(F, F.o(), F.wout_t() + (size_t)l * D * D, l == 0 ? MT : ML, D, 0, 0, 0, E); } break;
            case 4: ph_n2(F, l); break;
            case 5: ph_topk(F, l); break;
            case 6: { EpiNGateUp E{F.act()}; gemm_naive(F, F.xe(), F.wgu_t() + (size_t)l * NE * 2048 * D, NE * ER, 2048, ER, (size_t)2048 * D, l == 0 ? ER : NB * CAP, E); } break;
            case 7: { EpiNBf16 E{F.Y(), D}; gemm_naive(F, F.act(), F.wdn_t() + (size_t)l * NE * D * D, NE * ER, D, ER, (size_t)D * D, l == 0 ? ER : NB * CAP, E); } break;
            case 8: ph_n3(F, l); break;
            }
        }
        if (ph + 1 < hi) { __syncthreads(); xcd_barrier(bar); }
    }
}

extern "C" void kernel_launch(void* const* d_in, const int* in_sizes, int n_in, void* d_out, int out_size, void* d_ws, size_t ws_size, hipStream_t stream) {
    static int grid = 0;
    if (grid == 0) {
        if (n_in != 25 || out_size != ML * D || ws_size < WS_END) { fprintf(stderr, "kernel_launch: unexpected shapes (n_in %d, out %d, ws %zu)\n", n_in, out_size, ws_size); grid = -1; return; }
        int dev = 0, cus = 0;
        if (hipGetDevice(&dev) != hipSuccess || hipDeviceGetAttribute(&cus, hipDeviceAttributeMultiprocessorCount, dev) != hipSuccess) { grid = -1; return; }
        if (hipFuncSetAttribute((const void*)fwd_kernel, hipFuncAttributeMaxDynamicSharedMemorySize, LDS_BYTES) != hipSuccess) { fprintf(stderr, "kernel_launch: hipFuncSetAttribute failed\n"); grid = -1; return; }
        (void)hipGetLastError();
        grid = cus;
    }
    if (grid < 0) return;
    (void)hipMemsetAsync((char*)d_ws + WS_CTL, 0, CTL_ZERO_BYTES, stream);
    Args a{};
    for (int i = 0; i < 25; ++i) a.in[i] = (const float*)d_in[i];
    a.out = (float*)d_out; a.ws = (unsigned char*)d_ws;
#if MK_ONE_LAUNCH
    a.ph_lo = 0; a.ph_hi = NPHASE;
    hipLaunchKernelGGL(fwd_kernel, dim3(grid), dim3(NTHR), LDS_BYTES, stream, a);
#else
    for (int ph = 0; ph < NPHASE; ++ph) { a.ph_lo = ph; a.ph_hi = ph + 1; hipLaunchKernelGGL(fwd_kernel, dim3(grid), dim3(NTHR), LDS_BYTES, stream, a); }
#endif
}
```

```cpp
#include <hip/hip_runtime.h>
#include <cstdio>
#include <cstdint>

#ifndef MK_ONE_LAUNCH
#define MK_ONE_LAUNCH 1
#endif
#ifndef NAIVE_GEMM
#define NAIVE_GEMM 0
#endif
#ifndef NAIVE_ATTN
#define NAIVE_ATTN 0
#endif

#define LAS __attribute__((address_space(3)))
#define GAS __attribute__((address_space(1)))
typedef unsigned short bf16;
typedef unsigned v4u __attribute__((ext_vector_type(4)));
typedef unsigned v2u __attribute__((ext_vector_type(2)));
typedef float f32x4 __attribute__((ext_vector_type(4)));
typedef short bf16x8 __attribute__((ext_vector_type(8)));

constexpr int D = 1024, NB = 8, SEQ = 2048, LC = 256, DEPTH = 2, GRIDW = 64;
constexpr int ML = NB * SEQ, MC = NB * LC, MT = ML + MC;
constexpr int PROJ = 2560, NE = 16, CAP = 256, CAPC = 32, ER = NB * CAP + NB * CAPC;
constexpr float EPS = 1e-6f;
constexpr int NWAVES = 8, NTHR = 512;
__host__ __device__ constexpr int QOFF_(int m) { return m == 0 ? 0 : m == 1 ? 512 : m == 2 ? 1280 : 1792; }
__host__ __device__ constexpr int KOFF_(int m) { return m == 0 ? 256 : m == 1 ? 768 : m == 2 ? 1536 : 2048; }
__host__ __device__ constexpr int VOFF_(int m) { return m == 0 ? 384 : m == 1 ? 1024 : m == 2 ? 1664 : 2304; }

constexpr size_t MiB = 1u << 20;
constexpr size_t WS_CTL = 0, CTL_ZERO_BYTES = 1 * MiB;
constexpr size_t WS_MOD = 1 * MiB;
constexpr size_t WS_ROPE = 2 * MiB;
constexpr size_t WS_AFF = 3 * MiB;
constexpr size_t WS_SLOT = 5 * MiB;
constexpr size_t WS_GATE = 7 * MiB;
constexpr size_t WS_XC = 8 * MiB;
constexpr size_t WS_WIN = 16 * MiB;
constexpr size_t WS_WOUT = 26 * MiB;
constexpr size_t WS_WGU = 32 * MiB;
constexpr size_t WS_WDN = 160 * MiB;
constexpr size_t WS_H = 224 * MiB;
constexpr size_t WS_O = 260 * MiB;
constexpr size_t WS_P = 296 * MiB;
constexpr size_t WS_ACT = 386 * MiB;
constexpr size_t WS_XB = 458 * MiB;
constexpr size_t WS_END = 494 * MiB;

constexpr int RING_BYTES = 131072;
constexpr int LDSCTL_OFF = RING_BYTES, MISC_OFF = LDSCTL_OFF + 320;
constexpr int LDS_BYTES = 147456;

#define RLX_AGENT __ATOMIC_RELAXED, __HIP_MEMORY_SCOPE_AGENT
#define LDS_WAIT() asm volatile("s_waitcnt lgkmcnt(0)" ::: "memory")
#define VM_WAIT() asm volatile("s_waitcnt vmcnt(0)" ::: "memory")
__device__ __forceinline__ unsigned f2bf(float f) { unsigned u = __builtin_bit_cast(unsigned, f); return (u + 0x7fffu + ((u >> 16) & 1u)) >> 16; }
__device__ __forceinline__ unsigned pk2(float lo, float hi) { return f2bf(lo) | (f2bf(hi) << 16); }
#ifndef FP8_GEMMS
#define FP8_GEMMS 15
#endif
constexpr float WS8 = 64.f, AS_H = 8.f, AS_O = 32.f, AS_ACT = 8.f;
__device__ __forceinline__ unsigned pk4_fp8(float a, float b, float c, float d, float s) {
    a = __builtin_amdgcn_fmed3f(a * s, -448.f, 448.f); b = __builtin_amdgcn_fmed3f(b * s, -448.f, 448.f); c = __builtin_amdgcn_fmed3f(c * s, -448.f, 448.f); d = __builtin_amdgcn_fmed3f(d * s, -448.f, 448.f);
    int r = __builtin_amdgcn_cvt_pk_fp8_f32(a, b, 0, false); r = __builtin_amdgcn_cvt_pk_fp8_f32(c, d, r, true); return (unsigned)r;
}
__device__ __forceinline__ float bflo(unsigned u) { return __builtin_bit_cast(float, u << 16); }
__device__ __forceinline__ float bfhi(unsigned u) { return __builtin_bit_cast(float, u & 0xffff0000u); }
__device__ __forceinline__ float bf2f(bf16 u) { return __builtin_bit_cast(float, (unsigned)u << 16); }
#define DPP_ADD(v, ctrl, row_mask) ((v) + __builtin_bit_cast(float, __builtin_amdgcn_update_dpp(0, __builtin_bit_cast(int, (v)), (ctrl), (row_mask), 0xF, false)))
__device__ __forceinline__ float wave_sum(float v) {
    v = DPP_ADD(v, 0x128, 0xF);
    v = DPP_ADD(v, 0x124, 0xF);
    v = DPP_ADD(v, 0x122, 0xF);
    v = DPP_ADD(v, 0x121, 0xF);
    v = DPP_ADD(v, 0x142, 0xA);
    v = DPP_ADD(v, 0x143, 0xC);
    return __builtin_bit_cast(float, __builtin_amdgcn_readlane(__builtin_bit_cast(int, v), 63));
}
__device__ __forceinline__ void ld8(const bf16* p, float* f) {
    const v4u v = *(const v4u*)p;
    f[0] = bflo(v.x); f[1] = bfhi(v.x); f[2] = bflo(v.y); f[3] = bfhi(v.y); f[4] = bflo(v.z); f[5] = bfhi(v.z); f[6] = bflo(v.w); f[7] = bfhi(v.w);
}

#define XB_TMO      128
#define XB_XCNT(j)  (256  + 64 * (j))
#define XB_XSUB(j)  (1280 + 64 * (j))
#define XB_XGEN(j)  (2304 + 64 * (j))
#define XB_TOP      3328
#define XB_TOPGEN   3392
#define XCD_BAR_WORDS 3456
#define XB_SPIN_CAP (1u << 24)
__device__ __forceinline__ unsigned xb_ld(unsigned* p)              { return __hip_atomic_load(p, __ATOMIC_RELAXED, __HIP_MEMORY_SCOPE_AGENT); }
__device__ __forceinline__ unsigned xb_add(unsigned* p, unsigned v) { return __hip_atomic_fetch_add(p, v, __ATOMIC_RELAXED, __HIP_MEMORY_SCOPE_AGENT); }
__device__ __forceinline__ unsigned xb_xcc_id() { return (unsigned)__builtin_amdgcn_s_getreg((3 << 11) | 20) & 0xFu; }
#define XB_SPIN(cond, bar) do { unsigned _sp = 0; while (cond) { __builtin_amdgcn_s_sleep(1); \
    if ((++_sp & 255u) == 0u) { if (xb_ld(&(bar)[XB_TMO])) break; if (_sp > XB_SPIN_CAP) { atomicAdd(&(bar)[XB_TMO], 1u); break; } } } } while (0)
struct XcdBarrier { unsigned* bar; unsigned x; volatile LAS unsigned* st; };
__device__ __forceinline__ XcdBarrier xcd_barrier_post(unsigned* bar, volatile LAS unsigned* st) {
    XcdBarrier b; b.bar = bar; b.x = xb_xcc_id(); b.st = st;
    if (threadIdx.x == 0) (void)xb_add(&bar[XB_XCNT(b.x)], 1u);
    return b;
}
__device__ __forceinline__ void xcd_barrier_complete(unsigned* bar, unsigned x, unsigned& nloc, unsigned& nx) {
    const unsigned G = gridDim.x * gridDim.y * gridDim.z;
    unsigned sum, cnt, mine, sp = 0u;
    for (;;) {
        sum = 0u; cnt = 0u; mine = 0u;
#pragma unroll
        for (unsigned j = 0; j < 16; ++j) { const unsigned c = xb_ld(&bar[XB_XCNT(j)]); sum += c; cnt += (c > 0u) ? 1u : 0u; mine = (j == x) ? c : mine; }
        if (sum == G) break;
        __builtin_amdgcn_s_sleep(1);
        if ((++sp & 255u) == 0u) { if (xb_ld(&bar[XB_TMO])) break; if (sp > XB_SPIN_CAP) { atomicAdd(&bar[XB_TMO], 1u); break; } }
    }
    nloc = mine > 0u ? mine : 1u; nx = cnt > 0u ? cnt : 1u;
}
__device__ __forceinline__ void xcd_barrier(const XcdBarrier& b, bool grid = true) {
    asm volatile("s_waitcnt vmcnt(0)" ::: "memory");
    __syncthreads();
    if (threadIdx.x == 0) {
        unsigned* bar = b.bar;
        __builtin_amdgcn_s_waitcnt(0);
        unsigned nloc = b.st[0], nx = b.st[1];
        if (nloc == 0u) { xcd_barrier_complete(bar, b.x, nloc, nx); b.st[0] = nloc; b.st[1] = nx; }
        const unsigned old = xb_add(&bar[XB_XSUB(b.x)], 1u);
        const unsigned gen = old / nloc;
        if (old + 1u == (gen + 1u) * nloc) {
            if (grid) {
            __builtin_amdgcn_fence(__ATOMIC_RELEASE, "agent");
            asm volatile("s_waitcnt vmcnt(0)" ::: "memory");
            const unsigned og = xb_add(&bar[XB_TOP], 1u);
            const unsigned tg = og / nx;
            if (og + 1u == (tg + 1u) * nx) xb_add(&bar[XB_TOPGEN], 1u);
            else XB_SPIN(xb_ld(&bar[XB_TOPGEN]) == tg, bar);
            }
            __builtin_amdgcn_fence(__ATOMIC_ACQUIRE, "agent");
            xb_add(&bar[XB_XGEN(b.x)], 1u);
            asm volatile("s_waitcnt vmcnt(0)" ::: "memory");
        } else {
            XB_SPIN(xb_ld(&bar[XB_XGEN(b.x)]) == gen, bar);
            __builtin_amdgcn_fence(__ATOMIC_ACQUIRE, "agent");
            asm volatile("s_waitcnt vmcnt(0)" ::: "memory");
        }
    }
    __syncthreads();
}

namespace pg8 {
#define PG8_LAS __attribute__((address_space(3)))
typedef unsigned short bf16_t;
typedef short bf16x8 __attribute__((ext_vector_type(8)));
typedef float f32x4 __attribute__((ext_vector_type(4)));
typedef unsigned u32x4 __attribute__((ext_vector_type(4)));
constexpr int BM = 256, BK = 64, HALF = 128, HTB = HALF * BK * 2  , STAGE_BYTES = 8 * HTB, NXCD = 8, WGM = 8;

__host__ __device__ __forceinline__ int lds_byte(int r, int c) { const int st = (r >> 4) * 2 + (c >> 5), rr = r & 15, cc = c & 31, ob = rr * 64 + cc * 2; return st * 1024 + (ob ^ (((ob >> 9) & 1) << 5)); }
__host__ __device__ __forceinline__ void stage_rc(int b, int& R, int& C) { const int st = b / 1024, sb = b % 1024, swz = sb ^ (((sb >> 9) & 1) << 5); R = (st >> 1) * 16 + swz / 64; C = (st & 1) * 32 + (swz % 64) / 2; }
__host__ __device__ __forceinline__ int perm32(int rho) { const int n = rho >> 4, i = rho & 15; return 8 * (i >> 2) + 4 * n + (i & 3); }

struct Unit { int pm, pn; };
struct Gemm { const bf16_t* A; const bf16_t* Bt; int M, N, K; int tiles_per_group; size_t group_bytes; const int* gather; float dq = 1.f; };
__device__ __forceinline__ const char* gemm_bbase(const Gemm& g, const Unit& u, size_t tstep) { return (const char*)g.Bt + (g.tiles_per_group ? (size_t)(u.pm / g.tiles_per_group) * g.group_bytes : (size_t)0) + (size_t)u.pn * tstep; }

struct StaticOrder {
    int nM, nN, nwg, G, c;
    __host__ __device__ void init(int M, int N, int G_, int c_) { nM = M / BM; nN = N / BM; nwg = nM * nN; G = G_; c = c_; }
    __host__ __device__ bool next(int i, Unit& u) const {
        const long L = (long)i * G + c; if (L >= nwg) return false;
        int wgid = (int)L; { const int q = nwg / NXCD, r = nwg % NXCD, xcd = wgid % NXCD, off = wgid / NXCD; wgid = (xcd < r ? xcd * (q + 1) : r * (q + 1) + (xcd - r) * q) + off; }
        const int nig = WGM * nN, gid = wgid / nig, fm = gid * WGM, gsz = (nM - fm) < WGM ? (nM - fm) : WGM;
        u.pm = fm + ((wgid % nig) % gsz); u.pn = (wgid % nig) / gsz; return true;
    }
    __device__ __forceinline__ void a_ready(const Unit&) const {}
    __device__ __forceinline__ void done(const Unit&) const {}
};


__device__ __forceinline__ unsigned cvt_pk_bf16(float lo, float hi) { unsigned r; asm volatile("v_cvt_pk_bf16_f32 %0, %1, %2" : "=v"(r) : "v"(lo), "v"(hi)); return r; }
struct EpiF32 {
    static constexpr bool PERM = false, AFTER_DRAIN = false;
    float* C; int ldc;
    __device__ __forceinline__ void operator()(const f32x4 (&acc)[2][2][4][2], const Unit& u, int wr, int wc, int fr, int fq) const {
        const int row0 = u.pm * BM + wr * 64 + fr, col0 = u.pn * BM + wc * 32 + 4 * fq;
#pragma unroll
        for (int ai = 0; ai < 2; ++ai)
#pragma unroll
            for (int m = 0; m < 4; ++m) { float* rowp = C + (size_t)(row0 + ai * HALF + m * 16) * ldc + col0;
#pragma unroll
                for (int bj = 0; bj < 2; ++bj)
#pragma unroll
                    for (int n = 0; n < 2; ++n) *(f32x4*)(rowp + bj * HALF + n * 16) = acc[ai][bj][m][n]; }
    }
};
struct EpiBf16 {
    static constexpr bool PERM = true, AFTER_DRAIN = false;
    bf16_t* O; int ldc;
    __device__ __forceinline__ void operator()(const f32x4 (&acc)[2][2][4][2], const Unit& u, int wr, int wc, int fr, int fq) const {
        const int row0 = u.pm * BM + wr * 64 + fr, col0 = u.pn * BM + wc * 32 + 8 * fq;
#pragma unroll
        for (int ai = 0; ai < 2; ++ai)
#pragma unroll
            for (int m = 0; m < 4; ++m) { bf16_t* rowp = O + (size_t)(row0 + ai * HALF + m * 16) * ldc + col0;
#pragma unroll
                for (int bj = 0; bj < 2; ++bj) { const f32x4 v0 = acc[ai][bj][m][0], v1 = acc[ai][bj][m][1];
                    u32x4 w; w.x = cvt_pk_bf16(v0[0], v0[1]); w.y = cvt_pk_bf16(v0[2], v0[3]); w.z = cvt_pk_bf16(v1[0], v1[1]); w.w = cvt_pk_bf16(v1[2], v1[3]);
                    *(u32x4*)(rowp + bj * HALF) = w; } }
    }
};
struct EpiQKV {
    static constexpr bool PERM = true, AFTER_DRAIN = false;
    bf16_t* O; const float *cosA, *sinA, *cosB, *sinB, *qg, *kg; int n_lat_rows, seq, ldc;
    __device__ __forceinline__ void operator()(const f32x4 (&acc)[2][2][4][2], const Unit& u, int wr, int wc, int fr, int fq) const {
        const int pn = u.pn, row0 = u.pm * BM + wr * 64 + fr;
        int colb[2];
#pragma unroll
        for (int bj = 0; bj < 2; ++bj) { const int pb = 4 * bj + wc; int sb = pb;
            if (pn == 0) sb = 2 * (pb & 3) + (pb >> 2);
            else if (pn == 1) sb = (pb & 3) < 2 ? 2 * (pb & 3) + (pb >> 2) : (pb < 4 ? pb + 2 : pb);
            colb[bj] = pn * BM + 32 * sb + 8 * fq; }
        const bool donorm = (pn == 0) || (pn == 1 && wc < 2);
        const int rk0 = (pn == 0 || (pn == 1 && wc < 2) || pn == 5 || pn == 6) ? 1 : ((pn == 2 || pn == 3) ? 2 : 0);
        const int rk1 = (pn == 0 || (pn == 1 && wc < 2) || pn == 5) ? 1 : ((pn == 2 || pn == 3) ? 2 : 0);
        const int pa0 = (pn <= 1) ? 4 * fq : 16 * (wc & 1) + 4 * fq, pa1 = (pn <= 1) ? 16 + 4 * fq : 16 * (wc & 1) + 4 * fq;
        const int pb_ = 4 * fq;
        f32x4 fr0 = {0.f, 0.f, 0.f, 0.f}, fr1 = fr0; bool col0 = false, col1 = false;
        if (rk0) { const int p0 = rk0 == 1 ? pa0 : pb_, na = rk0 == 1 ? 16 : 8; col0 = p0 >= na;
#pragma unroll
            for (int i = 0; i < 4; ++i) fr0[i] = exp2f(-(float)((p0 + i) & (na - 1)) * (13.287712379549449f / (float)na)) * 0.15915494309189535f; }
        if (rk1) { const int p1 = rk1 == 1 ? pa1 : pb_, na = rk1 == 1 ? 16 : 8; col1 = p1 >= na;
#pragma unroll
            for (int i = 0; i < 4; ++i) fr1[i] = exp2f(-(float)((p1 + i) & (na - 1)) * (13.287712379549449f / (float)na)) * 0.15915494309189535f; }
        const float* gain = (pn == 0) ? qg : kg;
        f32x4 g00 = {1.f, 1.f, 1.f, 1.f}, g01 = g00, g10 = g00, g11 = g00;
        if (donorm) { g00 = *(const f32x4*)(gain + 8 * fq); g01 = *(const f32x4*)(gain + 8 * fq + 4); g10 = *(const f32x4*)(gain + 32 + 8 * fq); g11 = *(const f32x4*)(gain + 32 + 8 * fq + 4); }
#pragma unroll
        for (int ai = 0; ai < 2; ++ai)
#pragma unroll
            for (int m = 0; m < 4; ++m) {
                const int row = row0 + ai * HALF + m * 16;
                f32x4 v00 = acc[ai][0][m][0], v01 = acc[ai][0][m][1], v10 = acc[ai][1][m][0], v11 = acc[ai][1][m][1];
                if (donorm) {
                    float ss = (v00[0] * v00[0] + v00[1] * v00[1]) + (v00[2] * v00[2] + v00[3] * v00[3]) + (v01[0] * v01[0] + v01[1] * v01[1]) + (v01[2] * v01[2] + v01[3] * v01[3])
                             + (v10[0] * v10[0] + v10[1] * v10[1]) + (v10[2] * v10[2] + v10[3] * v10[3]) + (v11[0] * v11[0] + v11[1] * v11[1]) + (v11[2] * v11[2] + v11[3] * v11[3]);
                    ss += __shfl_xor(ss, 16); ss += __shfl_xor(ss, 32);
                    const float rstd = 1.0f / sqrtf(ss * (1.f / 64.f) + 1e-6f);
                    v00 = v00 * rstd * g00; v01 = v01 * rstd * g01; v10 = v10 * rstd * g10; v11 = v11 * rstd * g11;
                }
                if (row < n_lat_rows && (rk0 | rk1)) {
                    const int t = row % seq; const float prow = (float)(t >> 6), pcol = (float)(t & 63);
                    if (rk0) { f32x4 c, sv; const float ps = col0 ? pcol : prow;
#pragma unroll
                        for (int i = 0; i < 4; ++i) { const float rv = __builtin_amdgcn_fractf(ps * fr0[i]); c[i] = __builtin_amdgcn_cosf(rv); sv[i] = __builtin_amdgcn_sinf(rv); }
                        const f32x4 a = {v00[0] * c[0] - v00[1] * sv[0], v00[0] * sv[0] + v00[1] * c[0], v00[2] * c[1] - v00[3] * sv[1], v00[2] * sv[1] + v00[3] * c[1]};
                        const f32x4 b = {v01[0] * c[2] - v01[1] * sv[2], v01[0] * sv[2] + v01[1] * c[2], v01[2] * c[3] - v01[3] * sv[3], v01[2] * sv[3] + v01[3] * c[3]};
                        v00 = a; v01 = b; }
                    if (rk1) { f32x4 c, sv; const float ps = col1 ? pcol : prow;
#pragma unroll
                        for (int i = 0; i < 4; ++i) { const float rv = __builtin_amdgcn_fractf(ps * fr1[i]); c[i] = __builtin_amdgcn_cosf(rv); sv[i] = __builtin_amdgcn_sinf(rv); }
                        const f32x4 a = {v10[0] * c[0] - v10[1] * sv[0], v10[0] * sv[0] + v10[1] * c[0], v10[2] * c[1] - v10[3] * sv[1], v10[2] * sv[1] + v10[3] * c[1]};
                        const f32x4 b = {v11[0] * c[2] - v11[1] * sv[2], v11[0] * sv[2] + v11[1] * c[2], v11[2] * c[3] - v11[3] * sv[3], v11[2] * sv[3] + v11[3] * c[3]};
                        v10 = a; v11 = b; }
                }
                bf16_t* rowp = O + (size_t)row * ldc;
                u32x4 w; w.x = cvt_pk_bf16(v00[0], v00[1]); w.y = cvt_pk_bf16(v00[2], v00[3]); w.z = cvt_pk_bf16(v01[0], v01[1]); w.w = cvt_pk_bf16(v01[2], v01[3]);
                *(u32x4*)(rowp + colb[0]) = w;
                u32x4 x; x.x = cvt_pk_bf16(v10[0], v10[1]); x.y = cvt_pk_bf16(v10[2], v10[3]); x.z = cvt_pk_bf16(v11[0], v11[1]); x.w = cvt_pk_bf16(v11[2], v11[3]);
                *(u32x4*)(rowp + colb[1]) = x;
            }
    }
};
__device__ __forceinline__ float silu_fast(float a) { return a * __builtin_amdgcn_rcpf(1.0f + __expf(-a)); }
template <bool OUT8>
struct EpiGateUpT {
    static constexpr bool PERM = true, AFTER_DRAIN = false;
    bf16_t* O; int ldc;
    __device__ __forceinline__ void operator()(const f32x4 (&acc)[2][2][4][2], const Unit& u, int wr, int wc, int fr, int fq) const {
        const int row0 = u.pm * BM + wr * 64 + fr, col0 = u.pn * HALF + wc * 32 + 8 * fq;
#pragma unroll
        for (int ai = 0; ai < 2; ++ai)
#pragma unroll
            for (int m = 0; m < 4; ++m) { bf16_t* rowp = O + (size_t)(row0 + ai * HALF + m * 16) * ldc + col0;
                const f32x4 g0 = acc[ai][0][m][0], g1 = acc[ai][0][m][1], u0 = acc[ai][1][m][0], u1 = acc[ai][1][m][1];
                if constexpr (OUT8) {
                    unsigned char* rp8 = (unsigned char*)O + (size_t)(row0 + ai * HALF + m * 16) * ldc + col0;
                    const unsigned lo = pk4_fp8(silu_fast(g0[0]) * u0[0], silu_fast(g0[1]) * u0[1], silu_fast(g0[2]) * u0[2], silu_fast(g0[3]) * u0[3], AS_ACT);
                    const unsigned hi = pk4_fp8(silu_fast(g1[0]) * u1[0], silu_fast(g1[1]) * u1[1], silu_fast(g1[2]) * u1[2], silu_fast(g1[3]) * u1[3], AS_ACT);
                    typedef unsigned u32x2_ __attribute__((ext_vector_type(2))); u32x2_ w8; w8.x = lo; w8.y = hi; *(u32x2_*)rp8 = w8;
                } else {
                u32x4 w; w.x = cvt_pk_bf16(silu_fast(g0[0]) * u0[0], silu_fast(g0[1]) * u0[1]); w.y = cvt_pk_bf16(silu_fast(g0[2]) * u0[2], silu_fast(g0[3]) * u0[3]);
                w.z = cvt_pk_bf16(silu_fast(g1[0]) * u1[0], silu_fast(g1[1]) * u1[1]); w.w = cvt_pk_bf16(silu_fast(g1[2]) * u1[2], silu_fast(g1[3]) * u1[3]);
                *(u32x4*)rowp = w; } }
    }
};
struct BatchOrder {
    int nrt, nN, U, x, j;
    __device__ void init(int M, int N, int c) { nrt = (M / BM > 64) ? 9 : 8; nN = N / BM; U = nrt * nN; x = c & 7; j = c >> 3; }
    __device__ bool next(int i, Unit& u) const {
        const int q = i * 32 + j; if (q >= U) return false;
        const int pl = q / nN; u.pm = pl < 8 ? 8 * x + pl : 64 + x; u.pn = q % nN; return true;
    }
    __device__ __forceinline__ void a_ready(const Unit&) const {}
    __device__ __forceinline__ void done(const Unit&) const {}
};
struct GroupedOrder {
    int ngroups, tpg, tvalid, nN, nwg, G, c; bool pn_fast = false;
    __device__ void init(int ngroups_, int tpg_, int tvalid_, int nN_, int G_, int c_) { ngroups = ngroups_; tpg = tpg_; tvalid = tvalid_; nN = nN_; nwg = ngroups * tvalid * nN; G = G_; c = c_; }
    __device__ bool next(int i, Unit& u) const {
        const long L = (long)i * G + c; if (L >= nwg) return false;
        int wgid = (int)L; { const int q = nwg / NXCD, r = nwg % NXCD, xcd = wgid % NXCD, off = wgid / NXCD; wgid = (xcd < r ? xcd * (q + 1) : r * (q + 1) + (xcd - r) * q) + off; }
        const int per = tvalid * nN, e = wgid / per, rr = wgid % per;
        if (pn_fast) { u.pm = e * tpg + rr / nN; u.pn = rr % nN; }
        else { u.pm = e * tpg + rr % tvalid; u.pn = rr / tvalid; }
        return true;
    }
    __device__ __forceinline__ void a_ready(const Unit&) const {}
    __device__ __forceinline__ void done(const Unit&) const {}
};
constexpr int GIDX_LDS_OFF = STAGE_BYTES + 1024;
typedef int i32x4 __attribute__((ext_vector_type(4)));
typedef int i32x8 __attribute__((ext_vector_type(8)));
template <class Epi, class Sched, bool ALIGN_EPI = false, bool SP2 = false, bool GATHER = false, bool FP8 = false>
__device__ __forceinline__ void gemm_phase(PG8_LAS unsigned char* lds, const Gemm g, const Sched& S, const Epi& E) {
    static_assert(!GATHER || SP2, "GATHER is written for the SP2 loop");
    int tid_ = threadIdx.x; asm volatile("" : "+v"(tid_));
    const int tid = tid_, wid = __builtin_amdgcn_readfirstlane(tid >> 6), lane = tid & 63, wr = wid >> 2, wc = wid & 3, fr = lane & 15, fq = lane >> 4;
    const int K = g.K, nt = K / BK;
    unsigned voffA[2], voffB[2];
#pragma unroll
    for (int i = 0; i < 2; ++i) { int R, C; stage_rc(tid * 16 + i * 8192, R, C); const int Rb = Epi::PERM ? ((R & ~31) + perm32(R & 31)) : R;
        voffA[i] = (unsigned)(R * K + C) * 2u; voffB[i] = (unsigned)(Rb * K + C) * 2u; }
    unsigned offA[2][2] = {{0u, 0u}, {0u, 0u}}, offN[2][2] = {{0u, 0u}, {0u, 0u}}; int gslot[2] = {0, 0}; unsigned gcol[2] = {0u, 0u};
    if constexpr (GATHER) {
#pragma unroll
        for (int i = 0; i < 2; ++i) { int R, C; stage_rc(tid * 16 + i * 8192, R, C); gslot[i] = R; gcol[i] = (unsigned)C * 2u; }
    }
    const size_t kstep = (size_t)(BK * 2);
    const size_t hstep = (size_t)HALF * K * 2;
    const size_t tstep = 2 * hstep;
    const unsigned ldsw = (unsigned)wid * 1024u;
    const int aoff = lds_byte(wr * 64 + fr, fq * 8), boff = lds_byte(wc * 32 + fr, fq * 8);
#define PG8_SA(b, h) (((b) * 2 + (h)) * HTB)
#define PG8_SB(b, h) ((4 + (b) * 2 + (h)) * HTB)
#define PG8_STAGE(bufoff, gbase, voff) do { _Pragma("unroll") for (int _i = 0; _i < 2; ++_i) \
        __builtin_amdgcn_global_load_lds((const unsigned*)((const char*)(gbase) + (voff)[_i]), (PG8_LAS unsigned*)(lds + (bufoff) + ldsw + _i * 8192), 16, 0, 0); } while (0)
#define PG8_STAGE_A(bufoff, ptr, half, OFFS) do { if constexpr (GATHER) { PG8_STAGE(bufoff, ptr, OFFS[half]); } else { PG8_STAGE(bufoff, (ptr) + (half) * hstep, voffA); } } while (0)
#define PG8_LDA(dst, b, h) do { _Pragma("unroll") for (int m = 0; m < 4; ++m) _Pragma("unroll") for (int k = 0; k < 2; ++k) dst[m][k] = *(const PG8_LAS bf16x8*)(lds + PG8_SA(b, h) + aoff + m * 2048 + k * 1024); } while (0)
#define PG8_LDB(dst, b, h) do { _Pragma("unroll") for (int n = 0; n < 2; ++n) _Pragma("unroll") for (int k = 0; k < 2; ++k) dst[n][k] = *(const PG8_LAS bf16x8*)(lds + PG8_SB(b, h) + boff + n * 2048 + k * 1024); } while (0)
#define PG8_CAT(x0, x1) __builtin_shufflevector(__builtin_bit_cast(i32x4, x0), __builtin_bit_cast(i32x4, x1), 0, 1, 2, 3, 4, 5, 6, 7)
#define PG8_MMA(ai, bj, At, Bt) do { __builtin_amdgcn_s_setprio(1); \
        if constexpr (FP8) { _Pragma("unroll") for (int m = 0; m < 4; ++m) _Pragma("unroll") for (int n = 0; n < 2; ++n) \
            asm volatile("v_mfma_f32_16x16x128_f8f6f4 %0, %1, %2, %0" : "+v"(acc[ai][bj][m][n]) : "v"(PG8_CAT(Bt[n][0], Bt[n][1])), "v"(PG8_CAT(At[m][0], At[m][1]))); } \
        else { _Pragma("unroll") for (int m = 0; m < 4; ++m) _Pragma("unroll") for (int n = 0; n < 2; ++n) _Pragma("unroll") for (int k = 0; k < 2; ++k) \
            acc[ai][bj][m][n] = __builtin_amdgcn_mfma_f32_16x16x32_bf16(Bt[n][k], At[m][k], acc[ai][bj][m][n], 0, 0, 0); } \
        __builtin_amdgcn_s_setprio(0); } while (0)
#define PG8_WAIT_V(n) asm volatile("s_waitcnt vmcnt(" #n ")" ::: "memory")
#define PG8_WAIT_L(n) asm volatile("s_waitcnt lgkmcnt(" #n ")" ::: "memory")
#define PG8_BAR __builtin_amdgcn_s_barrier()
#define PG8_SCHED __builtin_amdgcn_sched_barrier(0)
    Unit cur, nxt; int ui = 0;
    if (!S.next(0, cur)) return;
    f32x4 acc[2][2][4][2];
#pragma unroll
    for (int a = 0; a < 2; ++a)
#pragma unroll
        for (int b = 0; b < 2; ++b)
#pragma unroll
            for (int m = 0; m < 4; ++m)
#pragma unroll
                for (int n = 0; n < 2; ++n) acc[a][b][m][n] = (f32x4){0.f, 0.f, 0.f, 0.f};
    bf16x8 At[4][2], B0[2][2], B1[2][2];
    const char* cA = GATHER ? (const char*)g.A : (const char*)g.A + (size_t)cur.pm * tstep; const char* cB = gemm_bbase(g, cur, tstep);
    if constexpr (GATHER) {
#pragma unroll
        for (int h = 0; h < 2; ++h)
#pragma unroll
            for (int i = 0; i < 2; ++i) offA[h][i] = (unsigned)g.gather[cur.pm * BM + h * HALF + gslot[i]] * (unsigned)(K * 2) + gcol[i];
    }
    S.a_ready(cur);
    if constexpr (SP2) {
        PG8_STAGE(PG8_SB(0, 0), cB, voffB); PG8_STAGE(PG8_SB(0, 1), cB + hstep, voffB); PG8_STAGE_A(PG8_SA(0, 0), cA, 0, offA); PG8_STAGE_A(PG8_SA(0, 1), cA, 1, offA);
        if (wr == 1) PG8_BAR;
        PG8_WAIT_V(2); PG8_BAR;
        PG8_STAGE(PG8_SB(1, 0), cB + kstep, voffB); PG8_STAGE_A(PG8_SA(1, 0), cA + kstep, 0, offA); PG8_STAGE(PG8_SB(1, 1), cB + hstep + kstep, voffB);
        PG8_WAIT_V(6); PG8_BAR;
    } else {
        PG8_STAGE(PG8_SB(0, 0), cB, voffB); PG8_STAGE(PG8_SA(0, 0), cA, voffA); PG8_STAGE(PG8_SB(0, 1), cB + hstep, voffB); PG8_STAGE(PG8_SA(0, 1), cA + hstep, voffA);
        if (wr == 1) PG8_BAR;
        PG8_WAIT_V(4); PG8_BAR;
        PG8_STAGE(PG8_SB(1, 0), cB + kstep, voffB); PG8_STAGE(PG8_SA(1, 0), cA + kstep, voffA); PG8_STAGE(PG8_SB(1, 1), cB + hstep + kstep, voffB);
        PG8_WAIT_V(6); PG8_BAR;
    }
    for (;;) {
        const bool has_next = S.next(ui + 1, nxt);
        const char* nA = GATHER ? cA : (has_next ? (const char*)g.A + (size_t)nxt.pm * tstep : cA); const char* nB = has_next ? gemm_bbase(g, nxt, tstep) : cB;
        if constexpr (GATHER) { if (has_next && wid == 0) {
            const int l4 = 4 * (int)__builtin_amdgcn_mbcnt_hi(~0u, __builtin_amdgcn_mbcnt_lo(~0u, 0u));
            __builtin_amdgcn_global_load_lds((const unsigned*)(g.gather + nxt.pm * BM + l4), (PG8_LAS unsigned*)(lds + GIDX_LDS_OFF + (ui & 1) * 1024), 16, 0, 0); } }
        for (int t = 0; t < nt; t += 2) {
            const bool last = (t == nt - 2);
            const char* a1 = cA + (size_t)(t + 1) * kstep;
            const char* a2 = last ? nA : cA + (size_t)(t + 2) * kstep; const char* b2 = last ? nB : cB + (size_t)(t + 2) * kstep;
            const char* a3 = a2 + kstep; const char* b3 = b2 + kstep;
            if (last && has_next) S.a_ready(nxt);
            unsigned offS[2][2] = {{0u, 0u}, {0u, 0u}};
            if constexpr (GATHER) {
                if (last) {
#pragma unroll
                    for (int h = 0; h < 2; ++h)
#pragma unroll
                        for (int i = 0; i < 2; ++i) offN[h][i] = has_next ? (*(const PG8_LAS unsigned*)(lds + GIDX_LDS_OFF + (ui & 1) * 1024 + (h * HALF + gslot[i]) * 4)) * (unsigned)(K * 2) + gcol[i] : offA[h][i];
                }
#pragma unroll
                for (int h = 0; h < 2; ++h)
#pragma unroll
                    for (int i = 0; i < 2; ++i) offS[h][i] = last ? offN[h][i] : offA[h][i];
            }
            if constexpr (SP2) {
            PG8_LDB(B0, 0, 0); PG8_LDB(B1, 0, 1); PG8_SCHED; PG8_LDA(At, 0, 0); PG8_STAGE_A(PG8_SA(1, 1), a1, 1, offA);
            PG8_WAIT_V(8); PG8_WAIT_L(0); PG8_BAR; PG8_MMA(0, 0, At, B0); PG8_MMA(0, 1, At, B1); PG8_BAR; PG8_SCHED;
            PG8_LDA(At, 0, 1); PG8_STAGE(PG8_SB(0, 0), b2, voffB); PG8_STAGE(PG8_SB(0, 1), b2 + hstep, voffB); PG8_STAGE_A(PG8_SA(0, 0), a2, 0, offS);
            PG8_WAIT_V(8); PG8_WAIT_L(0); PG8_BAR; PG8_MMA(1, 0, At, B0); PG8_MMA(1, 1, At, B1); PG8_BAR; PG8_SCHED;
            PG8_LDB(B0, 1, 0); PG8_LDB(B1, 1, 1); PG8_SCHED; PG8_LDA(At, 1, 0); PG8_STAGE_A(PG8_SA(0, 1), a2, 1, offS);
            PG8_WAIT_V(8); PG8_WAIT_L(0); PG8_BAR; PG8_MMA(0, 0, At, B0); PG8_MMA(0, 1, At, B1); PG8_BAR; PG8_SCHED;
            PG8_LDA(At, 1, 1); PG8_STAGE(PG8_SB(1, 0), b3, voffB); PG8_STAGE(PG8_SB(1, 1), b3 + hstep, voffB); PG8_STAGE_A(PG8_SA(1, 0), a3, 0, offS);
            PG8_WAIT_V(8); PG8_WAIT_L(0); PG8_BAR; PG8_MMA(1, 0, At, B0); PG8_MMA(1, 1, At, B1); PG8_BAR; PG8_SCHED;
            } else {
            PG8_LDB(B0, 0, 0); PG8_SCHED; PG8_LDA(At, 0, 0); PG8_STAGE(PG8_SA(1, 1), a1 + hstep, voffA);
            PG8_WAIT_L(8); PG8_BAR; PG8_WAIT_L(0); PG8_MMA(0, 0, At, B0); PG8_BAR; PG8_SCHED;
            PG8_LDB(B1, 0, 1); PG8_STAGE(PG8_SB(0, 0), b2, voffB);
            PG8_BAR; PG8_WAIT_L(0); PG8_MMA(0, 1, At, B1); PG8_BAR;
            PG8_LDA(At, 0, 1); PG8_STAGE(PG8_SA(0, 0), a2, voffA);
            PG8_BAR; PG8_WAIT_L(0); PG8_MMA(1, 0, At, B0); PG8_BAR; PG8_SCHED;
            PG8_STAGE(PG8_SB(0, 1), b2 + hstep, voffB);
            PG8_WAIT_V(6); PG8_BAR; PG8_MMA(1, 1, At, B1); PG8_BAR;
            PG8_LDB(B0, 1, 0); PG8_SCHED; PG8_LDA(At, 1, 0); PG8_STAGE(PG8_SA(0, 1), a2 + hstep, voffA);
            PG8_WAIT_L(8); PG8_BAR; PG8_WAIT_L(0); PG8_MMA(0, 0, At, B0); PG8_BAR; PG8_SCHED;
            PG8_LDB(B1, 1, 1); PG8_STAGE(PG8_SB(1, 0), b3, voffB);
            PG8_BAR; PG8_WAIT_L(0); PG8_MMA(0, 1, At, B1); PG8_BAR;
            PG8_LDA(At, 1, 1); PG8_STAGE(PG8_SA(1, 0), a3, voffA);
            PG8_BAR; PG8_WAIT_L(0); PG8_MMA(1, 0, At, B0); PG8_BAR; PG8_SCHED;
            PG8_STAGE(PG8_SB(1, 1), b3 + hstep, voffB);
            PG8_WAIT_V(6); PG8_BAR; PG8_MMA(1, 1, At, B1); PG8_BAR;
            }
        }
        if constexpr (ALIGN_EPI) { if (wr == 0) PG8_BAR; }
        if constexpr (FP8) { const float dq_ = g.dq; asm volatile("s_nop 15\n\ts_nop 15" ::: "memory");
#pragma unroll
            for (int a = 0; a < 2; ++a)
#pragma unroll
                for (int b = 0; b < 2; ++b)
#pragma unroll
                    for (int m = 0; m < 4; ++m)
#pragma unroll
                        for (int n = 0; n < 2; ++n) acc[a][b][m][n] *= dq_; }
        if constexpr (!Epi::AFTER_DRAIN) { E(acc, cur, wr, wc, fr, fq); S.done(cur); }
        if (!has_next) break;
#pragma unroll
        for (int a = 0; a < 2; ++a)
#pragma unroll
            for (int b = 0; b < 2; ++b)
#pragma unroll
                for (int m = 0; m < 4; ++m)
#pragma unroll
                    for (int n = 0; n < 2; ++n) acc[a][b][m][n] = (f32x4){0.f, 0.f, 0.f, 0.f};
        cur = nxt; cA = nA; cB = nB; ++ui;
        if constexpr (GATHER) {
#pragma unroll
            for (int h = 0; h < 2; ++h)
#pragma unroll
                for (int i = 0; i < 2; ++i) offA[h][i] = offN[h][i];
        }
        if constexpr (ALIGN_EPI) { if (wr == 1) PG8_BAR; }
    }
    PG8_WAIT_V(0);
    if constexpr (!ALIGN_EPI) { if (wr == 0) PG8_BAR; }
    PG8_BAR;
    if constexpr (Epi::AFTER_DRAIN) { E.fused(acc, cur, wr, wc, fr, fq, lds, wid, lane); S.done(cur); }
#undef PG8_SA
#undef PG8_SB
#undef PG8_STAGE
#undef PG8_STAGE_A
#undef PG8_LDA
#undef PG8_LDB
#undef PG8_MMA
#undef PG8_CAT
#undef PG8_WAIT_V
#undef PG8_WAIT_L
#undef PG8_BAR
#undef PG8_SCHED
}
}

struct Args { const float* in[25]; float* out; unsigned char* ws; int ph_lo, ph_hi; };
#define CAS __attribute__((address_space(4)))
struct Frame {
    LAS unsigned char* lds;
    int tid, lane, wave, G, bid;
    const CAS Args* ka;
    __device__ __forceinline__ const float* x() const { return ka->in[0]; }
    __device__ __forceinline__ const float* c() const { return ka->in[1]; }
    __device__ __forceinline__ const float* ctx() const { return ka->in[2]; }
    __device__ __forceinline__ const float* c_ctx() const { return ka->in[3]; }
    __device__ __forceinline__ const float* w_ada() const { return ka->in[4]; }
    __device__ __forceinline__ const float* b_ada() const { return ka->in[5]; }
    __device__ __forceinline__ const float* g_pre_mix() const { return ka->in[6]; }
    __device__ __forceinline__ const float* g_post_mix() const { return ka->in[7]; }
    __device__ __forceinline__ const float* g_pre_ffn() const { return ka->in[8]; }
    __device__ __forceinline__ const float* g_post_ffn() const { return ka->in[9]; }
    __device__ __forceinline__ const float* w_in() const { return ka->in[10]; }
    __device__ __forceinline__ const float* w_out() const { return ka->in[11]; }
    __device__ __forceinline__ const float* q_gain_a() const { return ka->in[12]; }
    __device__ __forceinline__ const float* k_gain_a() const { return ka->in[13]; }
    __device__ __forceinline__ const float* lam_q1() const { return ka->in[14]; }
    __device__ __forceinline__ const float* lam_k1() const { return ka->in[15]; }
    __device__ __forceinline__ const float* lam_q2() const { return ka->in[16]; }
    __device__ __forceinline__ const float* lam_k2() const { return ka->in[17]; }
    __device__ __forceinline__ const float* subln() const { return ka->in[18]; }
    __device__ __forceinline__ const float* sink() const { return ka->in[19]; }
    __device__ __forceinline__ const float* rpb() const { return ka->in[20]; }
    __device__ __forceinline__ const float* w_router() const { return ka->in[21]; }
    __device__ __forceinline__ const float* w_gate() const { return ka->in[22]; }
    __device__ __forceinline__ const float* w_up() const { return ka->in[23]; }
    __device__ __forceinline__ const float* w_down() const { return ka->in[24]; }
    __device__ __forceinline__ float* out() const { return ka->out; }
    __device__ __forceinline__ unsigned char* ws() const { return ka->ws; }
    __device__ __forceinline__ float* mod() const { return (float*)(ws() + WS_MOD); }
    __device__ __forceinline__ float* cosA() const { return (float*)(ws() + WS_ROPE); }
    __device__ __forceinline__ float* sinA() const { return cosA() + SEQ * 32; }
    __device__ __forceinline__ float* cosB() const { return cosA() + SEQ * 64; }
    __device__ __forceinline__ float* sinB() const { return cosA() + SEQ * 80; }
    __device__ __forceinline__ float* affT() const { return (float*)(ws() + WS_AFF); }
    __device__ __forceinline__ float* affcT() const { return affT() + NB * NE * SEQ; }
    __device__ __forceinline__ int* slot() const { return (int*)(ws() + WS_SLOT); }
    __device__ __forceinline__ int* slotc() const { return slot() + NB * SEQ * NE; }
    __device__ __forceinline__ float* gate() const { return (float*)(ws() + WS_GATE); }
    __device__ __forceinline__ int* rowidx() const { return (int*)(ws() + WS_GATE + 512 * 1024); }
    __device__ __forceinline__ float* xcw() const { return (float*)(ws() + WS_XC); }
    __device__ __forceinline__ bf16* xb() const { return (bf16*)(ws() + WS_XB); }
    __device__ __forceinline__ bf16* win_t() const { return (bf16*)(ws() + WS_WIN); }
    __device__ __forceinline__ bf16* wout_t() const { return (bf16*)(ws() + WS_WOUT); }
    __device__ __forceinline__ bf16* wgu_t() const { return (bf16*)(ws() + WS_WGU); }
    __device__ __forceinline__ bf16* wdn_t() const { return (bf16*)(ws() + WS_WDN); }
    __device__ __forceinline__ bf16* h() const { return (bf16*)(ws() + WS_H); }
    __device__ __forceinline__ bf16* o() const { return (bf16*)(ws() + WS_O); }
    __device__ __forceinline__ bf16* p() const { return (bf16*)(ws() + WS_P); }
    __device__ __forceinline__ float* op() const { return (float*)(ws() + WS_P); }
    __device__ __forceinline__ bf16* opb() const { return (bf16*)(ws() + WS_ACT); }
    __device__ __forceinline__ bf16* xe() const { return (bf16*)(ws() + WS_P); }
    __device__ __forceinline__ bf16* Y() const { return (bf16*)(ws() + WS_P); }
    __device__ __forceinline__ bf16* act() const { return (bf16*)(ws() + WS_ACT); }
};


#define FOR_ROWS(F, row, nrows_) \
    for (int it_ = 0, row = 0; ; ++it_) if (((F).G == 256) ? (it_ >= 9 || ((row = it_ < 8 ? ((F).bid & 7) * SEQ + ((F).bid >> 3) * 8 + (F).wave + 256 * it_ : ML + ((F).bid & 7) * LC + ((F).bid >> 3) * 8 + (F).wave), row >= (nrows_))) \
                                                            : ((row = (F).bid * NWAVES + (F).wave + it_ * (F).G * NWAVES), row >= (nrows_))) break; else

__device__ __forceinline__ void transpose_item(const float* W, int K, int N, bf16* WT, int k0, int n0, int dst_row0, LAS float* scr, int lane, bool out8) {
    float tv[32];
    const float* wp = W + (size_t)(k0 + (lane >> 5)) * N + n0 + (lane & 31);
    size_t wstride = (size_t)2 * N; asm volatile("" : "+v"(wstride));
#pragma unroll
    for (int i = 0; i < 32; ++i) { tv[i] = *wp; wp += wstride; }
#pragma unroll
    for (int i = 0; i < 32; ++i) scr[(2 * i + (lane >> 5)) * 33 + (lane & 31)] = tv[i];
    LDS_WAIT(); asm volatile("" ::: "memory");
    const int c = lane & 7;
#pragma unroll
    for (int j = 0; j < 4; ++j) { const int n = (lane >> 3) + 8 * j; const LAS float* s = scr + (8 * c) * 33 + n;
        if (out8) { v2u o8; o8.x = pk4_fp8(s[0 * 33], s[1 * 33], s[2 * 33], s[3 * 33], WS8); o8.y = pk4_fp8(s[4 * 33], s[5 * 33], s[6 * 33], s[7 * 33], WS8);
            *(v2u*)((unsigned char*)WT + (size_t)(dst_row0 + n) * K + k0 + 8 * c) = o8; }
        else {
        v4u o; o.x = pk2(s[0 * 33], s[1 * 33]); o.y = pk2(s[2 * 33], s[3 * 33]); o.z = pk2(s[4 * 33], s[5 * 33]); o.w = pk2(s[6 * 33], s[7 * 33]);
        *(v4u*)(WT + (size_t)(dst_row0 + n) * K + k0 + 8 * c) = o; } }
    LDS_WAIT(); asm volatile("" ::: "memory");
}

constexpr int CVT_I_IN = 16 * 80, CVT_I_OUT = 16 * 32, CVT_I_E = 16 * 32;
constexpr int CVT_N_IN = DEPTH * CVT_I_IN, CVT_N_OUT = DEPTH * CVT_I_OUT, CVT_N_EX = DEPTH * NE * 3 * CVT_I_E;
constexpr int CVT_N0 = CVT_N_IN + CVT_N_OUT + CVT_N_EX / 2, CVT_NT = CVT_N_IN + CVT_N_OUT + CVT_N_EX;
constexpr int CVT_W_QKV = 48 * NWAVES, CVT_W_OUT = 224 * NWAVES, CVT_W_GU = 128 * NWAVES, CVT_W_DN = 192 * NWAVES;
constexpr int CVT_A = CVT_N0 + 6 * CVT_W_QKV, CVT_B = CVT_A + 5 * CVT_W_OUT, CVT_C = CVT_B + 5 * CVT_W_GU;
static_assert(CVT_C < CVT_NT && (CVT_NT - CVT_C + CVT_W_DN - 1) / CVT_W_DN <= 6, "deferred conversion split");
#ifndef CVT_ATT
#define CVT_ATT 1
#endif
static_assert(!CVT_ATT || (FP8_GEMMS & 12) == 12, "CVT_ATT writes e4m3 expert weights");
constexpr int CVT_ATT_PER_WAVE = 12;
static_assert(CVT_N_EX / 2 == 256 * NWAVES * CVT_ATT_PER_WAVE, "CVT_ATT item split");
__device__ __forceinline__ void cvt_att_decode(Frame& F, int idx, const float*& W, unsigned char*& WT, int& k0, int& n0, int& drow) {
    const int r = idx - (CVT_N_IN + CVT_N_OUT), le = r / (3 * CVT_I_E), rem = r % (3 * CVT_I_E), which = rem / CVT_I_E, q = rem % CVT_I_E; k0 = (q / 32) * 64; n0 = (q % 32) * 32;
    if (which == 2) { W = F.w_down() + (size_t)le * D * D; WT = (unsigned char*)(F.wdn_t() + (size_t)le * D * D); drow = n0; }
    else { W = (which == 0 ? F.w_gate() : F.w_up()) + (size_t)le * D * D; WT = (unsigned char*)(F.wgu_t() + (size_t)le * 2048 * D); drow = 256 * (n0 / 128) + (n0 % 128) + (which == 1 ? 128 : 0); }
}
__device__ __forceinline__ void cvt_att_step(Frame& F, int cv0, int t, LAS unsigned char* cvb, int lane) {
    const int n = lane & 31, kh = lane >> 5;
    float tv[32];
    if (t >= 1) {
#pragma unroll
        for (int i = 0; i < 32; ++i) tv[i] = *(const LAS float*)(cvb + (32 * kh + i) * 128 + 4 * n);
        LDS_WAIT(); asm volatile("" ::: "memory");
    }
    if (t < CVT_ATT_PER_WAVE) {
        const float* W; unsigned char* WT; int k0, n0, drow; cvt_att_decode(F, cv0 + t, W, WT, k0, n0, drow);
        const float* src = W + (size_t)(k0 + (lane >> 3)) * D + n0 + (lane & 7) * 4;
#pragma unroll
        for (int j = 0; j < 8; ++j) __builtin_amdgcn_global_load_lds((const unsigned*)(src + (size_t)(8 * j) * D), (LAS unsigned*)(cvb + j * 1024), 16, 0, 0);
    }
    if (t >= 1) {
        const float* W; unsigned char* WT; int k0, n0, drow; cvt_att_decode(F, cv0 + t - 1, W, WT, k0, n0, drow);
        unsigned char* dst = WT + (size_t)(drow + n) * D + k0 + 32 * kh;
#pragma unroll
        for (int h = 0; h < 2; ++h) { v4u o; o.x = pk4_fp8(tv[16 * h + 0], tv[16 * h + 1], tv[16 * h + 2], tv[16 * h + 3], WS8); o.y = pk4_fp8(tv[16 * h + 4], tv[16 * h + 5], tv[16 * h + 6], tv[16 * h + 7], WS8);
            o.z = pk4_fp8(tv[16 * h + 8], tv[16 * h + 9], tv[16 * h + 10], tv[16 * h + 11], WS8); o.w = pk4_fp8(tv[16 * h + 12], tv[16 * h + 13], tv[16 * h + 14], tv[16 * h + 15], WS8);
            *(v4u*)(dst + 16 * h) = o; }
    }
}
__device__ __forceinline__ void convert_items(Frame& F, int begin, int end, int start, int stride) {
    LAS float* scr = (LAS float*)(F.lds + F.wave * 16384);
    for (int it = begin + start; it < end; it += stride) {
        int r = it; const float* W; bf16* WT; int N, k0, n0, drow; bool o8 = false;
        if (r < CVT_N_IN) { o8 = (FP8_GEMMS & 1) != 0; const int l = r / CVT_I_IN, q = r % CVT_I_IN; W = F.w_in() + (size_t)l * D * PROJ; WT = F.win_t() + (size_t)l * PROJ * D; N = PROJ; k0 = (q / 80) * 64; n0 = (q % 80) * 32; drow = n0;
            { const int sb = (n0 >> 5) & 7;
              if (n0 < 256) drow = 32 * (4 * (sb & 1) + (sb >> 1));
              else if (n0 < 512) drow = 256 + 32 * (sb < 4 ? 4 * (sb & 1) + (sb >> 1) : (sb < 6 ? sb - 2 : sb)); } }
        else if ((r -= CVT_N_IN) < CVT_N_OUT) { o8 = (FP8_GEMMS & 2) != 0; const int l = r / CVT_I_OUT, q = r % CVT_I_OUT; W = F.w_out() + (size_t)l * D * D; WT = F.wout_t() + (size_t)l * D * D; N = D; k0 = (q / 32) * 64; n0 = (q % 32) * 32; drow = n0; }
        else { r -= CVT_N_OUT; const int le = r / (3 * CVT_I_E), rem = r % (3 * CVT_I_E), which = rem / CVT_I_E, q = rem % CVT_I_E; N = D; k0 = (q / 32) * 64; n0 = (q % 32) * 32;
            o8 = (which == 2) ? (FP8_GEMMS & 8) != 0 : (FP8_GEMMS & 4) != 0;
            if (which == 2) { W = F.w_down() + (size_t)le * D * D; WT = F.wdn_t() + (size_t)le * D * D; drow = n0; }
            else { W = (which == 0 ? F.w_gate() : F.w_up()) + (size_t)le * D * D; WT = F.wgu_t() + (size_t)le * 2048 * D; drow = 256 * (n0 / 128) + (n0 % 128) + (which == 1 ? 128 : 0); } }
        transpose_item(W, D, N, WT, k0, n0, drow, scr, F.lane, o8);
    }
}

__device__ __forceinline__ void ph_prologue(Frame& F) {
    {
        LAS float* sl = (LAS float*)F.lds;
        LAS float* red = sl + 9 * 1024;
        for (int i = F.tid; i < 9 * 1024; i += NTHR) { const float v = (i < 8 * 1024) ? F.c()[i] : F.c_ctx()[i - 8 * 1024]; sl[i] = v / (1.f + expf(-v)); }
        __syncthreads();
        for (int it = F.bid; it < 2 * 96; it += F.G) {
            const int l = it / 96, n0 = (it % 96) * 64;
            const float* W = F.w_ada() + (size_t)l * D * 6144 + n0 + F.lane;
            float acc[9];
#pragma unroll
            for (int r = 0; r < 9; ++r) acc[r] = 0.f;
            const int kb = F.wave * 128;
            const float* wp = W + (size_t)kb * 6144;
            size_t wstr = 6144; asm volatile("" : "+v"(wstr));
#pragma unroll 1
            for (int k0 = 0; k0 < 128; k0 += 32) {
                float wv[32];
#pragma unroll
                for (int i = 0; i < 32; ++i) { wv[i] = *wp; wp += wstr; }
#pragma unroll
                for (int i = 0; i < 32; ++i) {
#pragma unroll
                    for (int r = 0; r < 9; ++r) acc[r] = fmaf(sl[r * 1024 + kb + k0 + i], wv[i], acc[r]); }
            }
#pragma unroll
            for (int r = 0; r < 9; ++r) red[(F.wave * 9 + r) * 64 + F.lane] = acc[r];
            __syncthreads();
            for (int i = F.tid; i < 9 * 64; i += NTHR) { const int r = i / 64, cl = i % 64; float s = 0.f;
#pragma unroll
                for (int w = 0; w < 8; ++w) s += red[(w * 9 + r) * 64 + cl];
                F.mod()[((size_t)l * 9 + r) * 6144 + n0 + cl] = s + F.b_ada()[l * 6144 + n0 + cl]; }
            __syncthreads();
        }
    }
    __syncthreads();
    {
        const size_t gt = (size_t)F.bid * NTHR + F.tid, NT = (size_t)F.G * NTHR;
        for (size_t i = gt; i < (size_t)SEQ * 48; i += NT) {
            const int t = (int)(i / 48), j = (int)(i % 48);
            const float row = (float)(t / GRIDW), col = (float)(t % GRIDW);
            const bool isA = j < 32; const int jb = isA ? j : j - 32, na = isA ? 16 : 8, ia = jb & (na - 1);
            const float inv = exp2f(-(float)ia * (13.287712379549449f / (float)na));
            const float ang = (jb < na ? row : col) * inv;
            const float kq = rintf(ang * 0.15915494309189535f);
            float rr = fmaf(-kq, 6.28125f, ang); rr = fmaf(-kq, 1.9353071795864769e-3f, rr);
            const float cv = cosf(rr), sv = sinf(rr);
            if (isA) { F.cosA()[t * 32 + j] = cv; F.sinA()[t * 32 + j] = sv; } else { F.cosB()[t * 16 + jb] = cv; F.sinB()[t * 16 + jb] = sv; }
        }
    }
}

__device__ __forceinline__ void norm_mod_store(const f32x4 (&v)[4], const float* g, const float* sh, const float* sc, bf16* dst, int lane) {
    float ss = 0.f;
#pragma unroll
    for (int j = 0; j < 4; ++j) ss += (v[j].x * v[j].x + v[j].y * v[j].y) + (v[j].z * v[j].z + v[j].w * v[j].w);
    const float rstd = 1.0f / sqrtf(wave_sum(ss) * (1.f / D) + EPS);
#pragma unroll
    for (int j = 0; j < 4; ++j) { const int c0 = 4 * lane + 256 * j;
        const f32x4 gg = *(const f32x4*)(g + c0), s1 = *(const f32x4*)(sh + c0), s2 = *(const f32x4*)(sc + c0);
        const f32x4 o = (v[j] * rstd * gg) * (1.0f + s2) + s1;
        if constexpr ((FP8_GEMMS & 1) != 0) *(unsigned*)((unsigned char*)dst + c0) = pk4_fp8(o.x, o.y, o.z, o.w, AS_H);
        else { v2u w; w.x = pk2(o.x, o.y); w.y = pk2(o.z, o.w);
        *(v2u*)(dst + c0) = w; } }
}
__device__ __forceinline__ void ph_norm1(Frame& F, int l) {
    const int gw = F.bid * NWAVES + F.wave, NGW = F.G * NWAVES;
    FOR_ROWS(F, row, MT) {
        const float* xr = row < ML ? F.x() + (size_t)row * D : F.ctx() + (size_t)(row - ML) * D;
        const float* md = F.mod() + ((size_t)l * 9 + (row < ML ? row / SEQ : 8)) * 6144;
        f32x4 v[4];
#pragma unroll
        for (int j = 0; j < 4; ++j) v[j] = *(const f32x4*)(xr + 4 * F.lane + 256 * j);
        norm_mod_store(v, F.g_pre_mix() + l * D, md, md + 1024, (FP8_GEMMS & 1) ? (bf16*)((unsigned char*)F.h() + (size_t)row * D) : F.h() + (size_t)row * D, F.lane);
    }
}

struct EpiNBf16 { bf16* C; int ldc;
    __device__ __forceinline__ void operator()(int row, int col, f32x4 lo, f32x4 hi) const {
        v2u a; a.x = pk2(lo.x, lo.y); a.y = pk2(lo.z, lo.w); *(v2u*)(C + (size_t)row * ldc + col) = a;
        v2u b; b.x = pk2(hi.x, hi.y); b.y = pk2(hi.z, hi.w); *(v2u*)(C + (size_t)row * ldc + col + 128) = b; } };
struct EpiNF32 { float* C; int ldc;
    __device__ __forceinline__ void operator()(int row, int col, f32x4 lo, f32x4 hi) const {
        *(f32x4*)(C + (size_t)row * ldc + col) = lo; *(f32x4*)(C + (size_t)row * ldc + col + 128) = hi; } };
__device__ __forceinline__ float silu_f(float a) { return a / (1.f + expf(-a)); }
struct EpiNGateUp { bf16* C;
    __device__ __forceinline__ void operator()(int row, int col, f32x4 lo, f32x4 hi) const {
        const int f = (col >> 8) * 128 + (col & 255);
        v2u a; a.x = pk2(silu_f(lo.x) * hi.x, silu_f(lo.y) * hi.y); a.y = pk2(silu_f(lo.z) * hi.z, silu_f(lo.w) * hi.w);
        *(v2u*)(C + (size_t)row * D + f) = a; } };

template <class Epi>
__device__ __forceinline__ void gemm_naive(Frame& F, const bf16* A, const bf16* Bt, int M, int N, int rows_per_group, size_t b_group_stride, int skip_from, const Epi& epi) {
    constexpr int K = D;
    LAS float* As = (LAS float*)F.lds;
    LAS float* Bs = As + 32 * 132;
    const int nNt = N / 256, nT = (M / 128) * nNt;
    const int ty = F.tid >> 5, tx = F.tid & 31;
    for (int tile = F.bid; tile < nT; tile += F.G) {
        const int mt = tile / nNt, nt = tile % nNt;
        if (rows_per_group && ((mt * 128) % rows_per_group) >= skip_from) continue;
        const bf16* Ab = A + (size_t)mt * 128 * K;
        const bf16* Bb = Bt + (rows_per_group ? (size_t)((mt * 128) / rows_per_group) * b_group_stride : 0) + (size_t)nt * 256 * K;
        float acc[8][8];
#pragma unroll
        for (int i = 0; i < 8; ++i)
#pragma unroll
            for (int j = 0; j < 8; ++j) acc[i][j] = 0.f;
        for (int k0 = 0; k0 < K; k0 += 32) {
            { const int r = F.tid >> 2, kc = (F.tid & 3) * 8; float f[8]; ld8(Ab + (size_t)r * K + k0 + kc, f);
#pragma unroll
              for (int i = 0; i < 8; ++i) As[(kc + i) * 132 + r] = f[i]; }
#pragma unroll
            for (int hh = 0; hh < 2; ++hh) { const int r = (F.tid >> 2) + hh * 128, kc = (F.tid & 3) * 8; float f[8]; ld8(Bb + (size_t)r * K + k0 + kc, f);
#pragma unroll
              for (int i = 0; i < 8; ++i) Bs[(kc + i) * 260 + r] = f[i]; }
            __syncthreads();
#pragma unroll 4
            for (int kk = 0; kk < 32; ++kk) {
                const f32x4 a0 = *(const LAS f32x4*)(As + kk * 132 + ty * 8), a1 = *(const LAS f32x4*)(As + kk * 132 + ty * 8 + 4);
                const f32x4 b0 = *(const LAS f32x4*)(Bs + kk * 260 + tx * 4), b1 = *(const LAS f32x4*)(Bs + kk * 260 + 128 + tx * 4);
                const float a[8] = {a0.x, a0.y, a0.z, a0.w, a1.x, a1.y, a1.z, a1.w};
                const float b[8] = {b0.x, b0.y, b0.z, b0.w, b1.x, b1.y, b1.z, b1.w};
#pragma unroll
                for (int i = 0; i < 8; ++i)
#pragma unroll
                    for (int j = 0; j < 8; ++j) acc[i][j] = fmaf(a[i], b[j], acc[i][j]);
            }
            __syncthreads();
        }
#pragma unroll
        for (int i = 0; i < 8; ++i) epi(mt * 128 + ty * 8 + i, nt * 256 + tx * 4, (f32x4){acc[i][0], acc[i][1], acc[i][2], acc[i][3]}, (f32x4){acc[i][4], acc[i][5], acc[i][6], acc[i][7]});
    }
}

__device__ __forceinline__ void prep_seg(bf16* seg, int width, int lane, bool do_norm, const float* gain, bool do_rope, const float* cs, const float* sn, int dim  ) {
    if (lane * 4 >= width) return;
    const v2u raw = *(const v2u*)(seg + 4 * lane);
    float v[4] = {bflo(raw.x), bfhi(raw.x), bflo(raw.y), bfhi(raw.y)};
    const int d0 = (4 * lane) % dim;
    if (do_norm) {
        float ss = v[0] * v[0] + v[1] * v[1] + v[2] * v[2] + v[3] * v[3];
        ss += __shfl_xor(ss, 1); ss += __shfl_xor(ss, 2); ss += __shfl_xor(ss, 4); ss += __shfl_xor(ss, 8);
        const float rstd = 1.0f / sqrtf(ss * (1.f / 64.f) + EPS);
#pragma unroll
        for (int i = 0; i < 4; ++i) v[i] = v[i] * rstd * gain[d0 + i];
    }
    if (do_rope) {
        const int pi = d0 >> 1;
        const float c0 = cs[pi], s0 = sn[pi], c1 = cs[pi + 1], s1 = sn[pi + 1];
        const float a0 = v[0] * c0 - v[1] * s0, a1 = v[0] * s0 + v[1] * c0, a2 = v[2] * c1 - v[3] * s1, a3 = v[2] * s1 + v[3] * c1;
        v[0] = a0; v[1] = a1; v[2] = a2; v[3] = a3;
    }
    v2u w; w.x = pk2(v[0], v[1]); w.y = pk2(v[2], v[3]);
    *(v2u*)(seg + 4 * lane) = w;
}
__device__ __forceinline__ void ph_prep(Frame& F, int l) {
    const int gw = F.bid * NWAVES + F.wave, NGW = F.G * NWAVES;
    FOR_ROWS(F, row, MT) {
        bf16* pr = F.p() + (size_t)row * PROJ;
        const bool lat = row < ML; const int t = lat ? row % SEQ : 0;
        const float *ca = F.cosA() + t * 32, *sa = F.sinA() + t * 32, *cb = F.cosB() + t * 16, *sb = F.sinB() + t * 16;
        {
            const v2u raw = *(const v2u*)(pr + 4 * F.lane);
            float v[4] = {bflo(raw.x), bfhi(raw.x), bflo(raw.y), bfhi(raw.y)};
            const v2u rawk = *(const v2u*)(pr + 256 + 4 * (F.lane & 31));
            float kx[4] = {bflo(rawk.x), bfhi(rawk.x), bflo(rawk.y), bfhi(rawk.y)};
            float ss = v[0] * v[0] + v[1] * v[1] + v[2] * v[2] + v[3] * v[3];
            float sk = kx[0] * kx[0] + kx[1] * kx[1] + kx[2] * kx[2] + kx[3] * kx[3];
            ss += __shfl_xor(ss, 1); ss += __shfl_xor(ss, 2); ss += __shfl_xor(ss, 4); ss += __shfl_xor(ss, 8);
            sk += __shfl_xor(sk, 1); sk += __shfl_xor(sk, 2); sk += __shfl_xor(sk, 4); sk += __shfl_xor(sk, 8);
            const float rq = 1.0f / sqrtf(ss * (1.f / 64.f) + EPS), rk = 1.0f / sqrtf(sk * (1.f / 64.f) + EPS);
            const int d0 = (4 * F.lane) & 63;
            const float* gq = F.q_gain_a() + l * 64 + d0; const float* gk = F.k_gain_a() + l * 64 + d0;
#pragma unroll
            for (int i = 0; i < 4; ++i) { v[i] = v[i] * rq * gq[i]; kx[i] = kx[i] * rk * gk[i]; }
            if (lat) { const int pi = d0 >> 1; const float c0 = ca[pi], s0 = sa[pi], c1 = ca[pi + 1], s1 = sa[pi + 1];
                float a0 = v[0] * c0 - v[1] * s0, a1 = v[0] * s0 + v[1] * c0, a2 = v[2] * c1 - v[3] * s1, a3 = v[2] * s1 + v[3] * c1;
                v[0] = a0; v[1] = a1; v[2] = a2; v[3] = a3;
                a0 = kx[0] * c0 - kx[1] * s0; a1 = kx[0] * s0 + kx[1] * c0; a2 = kx[2] * c1 - kx[3] * s1; a3 = kx[2] * s1 + kx[3] * c1;
                kx[0] = a0; kx[1] = a1; kx[2] = a2; kx[3] = a3; }
            v2u w; w.x = pk2(v[0], v[1]); w.y = pk2(v[2], v[3]); *(v2u*)(pr + 4 * F.lane) = w;
            if (F.lane < 32) { v2u wk; wk.x = pk2(kx[0], kx[1]); wk.y = pk2(kx[2], kx[3]); *(v2u*)(pr + 256 + 4 * F.lane) = wk; }
        }
        if (lat) {
            prep_seg(pr + 512, 256, F.lane, false, nullptr, true, cb, sb, 32);
            prep_seg(pr + 768, 256, F.lane, false, nullptr, true, cb, sb, 32);
            prep_seg(pr + 1280, 256, F.lane, false, nullptr, true, ca, sa, 64);
            prep_seg(pr + 1536, 128, F.lane, false, nullptr, true, ca, sa, 64);
        }
    }
}

__device__ __forceinline__ void ldrow64(const bf16* p, float* f) {
#pragma unroll
    for (int i = 0; i < 8; ++i) ld8(p + 8 * i, f + 8 * i);
}
template <int MIX>
__device__ __forceinline__ void attn_naive_q(Frame& F, int l, int b, int h, int qi, bool isctx) {
    const bf16* P = F.p();
    const size_t qrow = isctx ? (size_t)(ML + b * LC + qi) : (size_t)(b * SEQ + qi);
    const int kvh = (MIX == 0 || MIX == 2) ? (h >> 1) : h;
    const int qo = QOFF_(MIX) + h * 64, ko = KOFF_(MIX) + kvh * 64, vo = VOFF_(MIX) + kvh * 64;
    float q[64]; ldrow64(P + qrow * PROJ + qo, q);
    float o[64];
#pragma unroll
    for (int d = 0; d < 64; ++d) o[d] = 0.f;
    const size_t crow0 = (size_t)(ML + b * LC), lrow0 = (size_t)b * SEQ;
    if (MIX != 1) {
#pragma unroll
        for (int d = 0; d < 64; ++d) q[d] *= 0.125f;
        float m = -INFINITY, ls = 0.f;
        if (MIX == 2) { m = F.sink()[l * 4 + h]; ls = 1.f; }
        const int r_ = qi / GRIDW, cq_ = qi % GRIDW;
        int rs_ = r_ - 4; rs_ = rs_ < 0 ? 0 : (rs_ > 24 ? 24 : rs_);
        int cs_ = cq_ - 8; cs_ = cs_ < 0 ? 0 : (cs_ > 48 ? 48 : cs_);
        const int nk = LC + (isctx ? 0 : (MIX == 0 ? SEQ : (MIX == 2 ? 257 : 128)));
        for (int j = 0; j < nk; ++j) {
            size_t krow = crow0 + j; float bias = 0.f; bool valid = true;
            if (j >= LC) { const int jj = j - LC;
                if (MIX == 0) krow = lrow0 + jj;
                if (MIX == 2) { const int t2 = qi - 128 + jj; valid = (t2 >= 0 && t2 < SEQ); krow = lrow0 + (valid ? t2 : 0); }
                if (MIX == 3) { const int kr = jj >> 4, w = cs_ + (jj & 15); const int ri = rs_ + kr - r_ + 7; int ci = w - cq_ + 15; ci = ci < 0 ? 0 : (ci > 30 ? 30 : ci);
                    krow = lrow0 + (size_t)(rs_ + kr) * GRIDW + w; bias = F.rpb()[((l * 4 + h) * 15 + ri) * 31 + ci]; } }
            if (valid) {
                float s = 0.f;
#pragma unroll
                for (int c8 = 0; c8 < 8; ++c8) { float kf[8]; ld8(P + krow * PROJ + ko + 8 * c8, kf);
#pragma unroll
                    for (int i = 0; i < 8; ++i) s = fmaf(q[8 * c8 + i], kf[i], s);
                    if (c8 & 1) asm volatile("" ::: "memory"); }
                s += bias;
                const float mn = fmaxf(m, s), cr = expf(m - mn), pe = expf(s - mn);
                ls = ls * cr + pe;
#pragma unroll
                for (int c8 = 0; c8 < 8; ++c8) { float kf[8]; ld8(P + krow * PROJ + vo + 8 * c8, kf);
#pragma unroll
                    for (int i = 0; i < 8; ++i) o[8 * c8 + i] = o[8 * c8 + i] * cr + pe * kf[i];
                    if (c8 & 1) asm volatile("" ::: "memory"); }
                m = mn;
            }
        }
        const float inv = 1.f / ls;
#pragma unroll
        for (int d = 0; d < 64; ++d) o[d] *= inv;
    } else {
        const float sc = 0.17677669529663687f;
#pragma unroll
        for (int d = 0; d < 64; ++d) q[d] *= sc;
        float m1 = -INFINITY, l1 = 0.f, m2 = -INFINITY, l2 = 0.f;
        const int nk = isctx ? LC : LC + SEQ;
        for (int j = 0; j < nk; ++j) { const size_t krow = j < LC ? crow0 + j : lrow0 + (j - LC);
            float s1 = 0.f, s2 = 0.f;
#pragma unroll
            for (int c8 = 0; c8 < 4; ++c8) { float kf[8], kg[8]; ld8(P + krow * PROJ + ko + 8 * c8, kf); ld8(P + krow * PROJ + ko + 32 + 8 * c8, kg);
#pragma unroll
                for (int i = 0; i < 8; ++i) { s1 = fmaf(q[8 * c8 + i], kf[i], s1); s2 = fmaf(q[32 + 8 * c8 + i], kg[i], s2); }
                asm volatile("" ::: "memory"); }
            float mn = fmaxf(m1, s1); l1 = l1 * expf(m1 - mn) + expf(s1 - mn); m1 = mn;
            mn = fmaxf(m2, s2); l2 = l2 * expf(m2 - mn) + expf(s2 - mn); m2 = mn; }
        float d1 = 0.f, d2 = 0.f;
        for (int i = 0; i < 32; ++i) { d1 += F.lam_q1()[l * 32 + i] * F.lam_k1()[l * 32 + i]; d2 += F.lam_q2()[l * 32 + i] * F.lam_k2()[l * 32 + i]; }
        const float lam_init = 0.8f - 0.6f * expf(-0.3f * (float)l);
        const float lam = expf(d1) - expf(d2) + lam_init;
        const float i1 = 1.f / l1, i2 = lam / l2;
        for (int j = 0; j < nk; ++j) { const size_t krow = j < LC ? crow0 + j : lrow0 + (j - LC);
            float s1 = 0.f, s2 = 0.f;
#pragma unroll
            for (int c8 = 0; c8 < 4; ++c8) { float kf[8], kg[8]; ld8(P + krow * PROJ + ko + 8 * c8, kf); ld8(P + krow * PROJ + ko + 32 + 8 * c8, kg);
#pragma unroll
                for (int i = 0; i < 8; ++i) { s1 = fmaf(q[8 * c8 + i], kf[i], s1); s2 = fmaf(q[32 + 8 * c8 + i], kg[i], s2); }
                asm volatile("" ::: "memory"); }
            const float a = expf(s1 - m1) * i1 - expf(s2 - m2) * i2;
#pragma unroll
            for (int c8 = 0; c8 < 8; ++c8) { float kf[8]; ld8(P + krow * PROJ + vo + 8 * c8, kf);
#pragma unroll
                for (int i = 0; i < 8; ++i) o[8 * c8 + i] = fmaf(a, kf[i], o[8 * c8 + i]);
                if (c8 & 1) asm volatile("" ::: "memory"); } }
        float ss = 0.f;
#pragma unroll
        for (int d = 0; d < 64; ++d) ss += o[d] * o[d];
        const float rstd = 1.0f / sqrtf(ss * (1.f / 64.f) + EPS) * (1.f - lam_init);
#pragma unroll
        for (int d = 0; d < 64; ++d) o[d] = o[d] * rstd * F.subln()[l * 64 + d];
    }
    bf16* orow = F.o() + qrow * D + MIX * 256 + h * 64;
#pragma unroll
    for (int d = 0; d < 64; d += 8) { v4u w; w.x = pk2(o[d], o[d + 1]); w.y = pk2(o[d + 2], o[d + 3]); w.z = pk2(o[d + 4], o[d + 5]); w.w = pk2(o[d + 6], o[d + 7]); *(v4u*)(orow + d) = w; }
}
__device__ __forceinline__ void ph_attn_naive(Frame& F, int l) {
    const int nitems = 512 + (l == 0 ? 128 : 0);
    for (int it = F.bid; it < nitems; it += F.G) {
        if (it < 512) { const int mo = it / 128, r = it % 128, b = r / 16, h = (r / 4) % 4, ch = r % 4, qi = ch * 512 + F.tid;
            if (mo == 0) attn_naive_q<1>(F, l, b, h, qi, false); else if (mo == 1) attn_naive_q<0>(F, l, b, h, qi, false);
            else if (mo == 2) attn_naive_q<3>(F, l, b, h, qi, false); else attn_naive_q<2>(F, l, b, h, qi, false); }
        else { const int r = it - 512, mix = r / 32, b = (r / 4) % 8, h = r % 4;
            if (F.tid < LC) { if (mix == 0) attn_naive_q<0>(F, l, b, h, F.tid, true); else if (mix == 1) attn_naive_q<1>(F, l, b, h, F.tid, true);
                else if (mix == 2) attn_naive_q<2>(F, l, b, h, F.tid, true); else attn_naive_q<3>(F, l, b, h, F.tid, true); } }
    }
}


namespace fa {
typedef float f32x16 __attribute__((ext_vector_type(16)));
typedef short s16x4 __attribute__((ext_vector_type(4)));
typedef short v4i16_t __attribute__((ext_vector_type(4)));
constexpr float LOG2E = 1.4426950408889634f, NEG = -1e30f;
constexpr int K_OFF = 0, V_OFF = 3 * 8192;
constexpr int BT_OFF = V_OFF + 2 * 8192;
constexpr int Q_OFF = BT_OFF + 2048;
constexpr int DB_OFF = Q_OFF + 32768;
constexpr int DP_OFF = DB_OFF + 15 * 512;
__device__ __forceinline__ int crow(int r, int hi) { return (r & 3) + 8 * (r >> 2) + 4 * hi; }
typedef float f32x2_t __attribute__((ext_vector_type(2))); typedef __bf16 bf16x2_t __attribute__((ext_vector_type(2)));
__device__ __forceinline__ unsigned cvtpk(float lo, float hi) { f32x2_t v = {lo, hi}; bf16x2_t b = __builtin_convertvector(v, bf16x2_t); return __builtin_bit_cast(unsigned, b); }
__device__ __forceinline__ s16x4 vtr(const LAS unsigned char* p) { return __builtin_bit_cast(s16x4, __builtin_amdgcn_ds_read_tr16_b64_v4i16((LAS v4i16_t*)p)); }
__device__ __forceinline__ float xhalf_max(float v) { return fmaxf(v, __shfl_xor(v, 32)); }

struct State { float m, l; f32x16 o[2]; };

constexpr float THR = 8.0f;
__device__ __forceinline__ void softmax_pv(State& st, f32x16& s0, f32x16& s1, float ref_used, bool first, const LAS unsigned char* Vb, int vb0) {
    float ta = fmaxf(fmaxf(s0[0], s0[1]), s1[0]), tb = fmaxf(fmaxf(s0[2], s0[3]), s1[1]);
    ta = fmaxf(fmaxf(ta, s1[2]), s1[3]);
#pragma unroll
    for (int r = 4; r < 16; r += 4) { ta = fmaxf(fmaxf(ta, s0[r]), s0[r + 1]); tb = fmaxf(fmaxf(tb, s0[r + 2]), s0[r + 3]); ta = fmaxf(fmaxf(ta, s1[r]), s1[r + 1]); tb = fmaxf(fmaxf(tb, s1[r + 2]), s1[r + 3]); }
    float tm = fmaxf(ta, tb);
    { auto rr = __builtin_amdgcn_permlane32_swap(__builtin_bit_cast(unsigned, tm), __builtin_bit_cast(unsigned, tm), false, false);
      tm = fmaxf(__builtin_bit_cast(float, rr[0]), __builtin_bit_cast(float, rr[1])); }
    const float adj = st.m - ref_used;
    tm -= adj;
    if (first || __any(tm > THR) || __any(adj != 0.f)) {
        const float dl = first ? tm : fmaxf(tm, 0.f), sub = adj + dl;
        st.m += dl;
        const float al = __builtin_amdgcn_exp2f(-dl);
        st.l *= al;
#pragma unroll
        for (int r = 0; r < 16; ++r) { s0[r] -= sub; s1[r] -= sub; st.o[0][r] *= al; st.o[1][r] *= al; }
    }
    float ps0 = 0.f, ps1 = 0.f;
#pragma unroll
    for (int r = 0; r < 16; ++r) { s0[r] = __builtin_amdgcn_exp2f(s0[r]); s1[r] = __builtin_amdgcn_exp2f(s1[r]); ps0 += s0[r]; ps1 += s1[r]; }
    st.l += ps0 + ps1;
#pragma unroll
    for (int kb = 0; kb < 2; ++kb)
#pragma unroll
        for (int sh = 0; sh < 2; ++sh) {
            const f32x16& sv = kb ? s1 : s0;
            v4u pw; pw.x = cvtpk(sv[8 * sh + 0], sv[8 * sh + 1]); pw.y = cvtpk(sv[8 * sh + 2], sv[8 * sh + 3]); pw.z = cvtpk(sv[8 * sh + 4], sv[8 * sh + 5]); pw.w = cvtpk(sv[8 * sh + 6], sv[8 * sh + 7]);
            const bf16x8 pf = __builtin_bit_cast(bf16x8, pw);
            const int ks = kb * 2 + sh;
#pragma unroll
            for (int db = 0; db < 2; ++db) {
                const s16x4 lo = vtr(Vb + vb0 + db * 4096 + ks * 1024), hv = vtr(Vb + vb0 + db * 4096 + ks * 1024 + 512);
                const bf16x8 vf = (bf16x8){lo[0], lo[1], lo[2], lo[3], hv[0], hv[1], hv[2], hv[3]};
                st.o[db] = __builtin_amdgcn_mfma_f32_32x32x16_bf16(vf, pf, st.o[db], 0, 0, 0);
            }
        }
}

template <int MIX, int KS0, int NKS>
__device__ __forceinline__ void qk_tile(f32x16& s0, f32x16& s1, float ref, const LAS unsigned char* Kb, const bf16x8 (&qf)[4], const LAS unsigned char* qlds, int r32, int hi,
                                        bool lat, int j, int qpos, int rq, int cq, int csq, const LAS unsigned char* lds, int bt_off) {
#define FA_QF(ks) ((MIX == 1) ? *(const LAS bf16x8*)(qlds + (ks) * 1024) : qf[ks])
    { f32x16 negm;
#pragma unroll
      for (int r = 0; r < 16; ++r) negm[r] = -ref;
      s0 = negm; s1 = negm; }
#pragma unroll
    for (int kk = 0; kk < NKS; ++kk) { const int ks = KS0 + kk;
        const bf16x8 k0 = *(const LAS bf16x8*)(Kb + (2 * ks + hi) * 1024 + r32 * 16), k1 = *(const LAS bf16x8*)(Kb + (2 * ks + hi) * 1024 + 512 + r32 * 16);
        const bf16x8 qv = FA_QF(ks);
        s0 = __builtin_amdgcn_mfma_f32_32x32x16_bf16(k0, qv, s0, 0, 0, 0);
        s1 = __builtin_amdgcn_mfma_f32_32x32x16_bf16(k1, qv, s1, 0, 0, 0); }
    if (MIX == 2 && lat) {
#pragma unroll
        for (int r = 0; r < 16; ++r) { const int kp = 64 * j + crow(r, hi), d0 = kp - qpos, d1 = kp + 32 - qpos;
            s0[r] = (d0 <= 128 && d0 >= -128) ? s0[r] : NEG; s1[r] = (d1 <= 128 && d1 >= -128) ? s1[r] : NEG; }
    } else if (MIX == 3 && lat) {
        const LAS unsigned char* pb = lds + DB_OFF + (j - rq + 7) * 512 + (63 - cq + 4 * hi) * 4;
        const LAS unsigned char* pp = lds + DP_OFF + (48 - csq + 4 * hi) * 4;
#pragma unroll
        for (int r = 0; r < 16; ++r) { const int wc4 = ((r & 3) + 8 * (r >> 2)) * 4;
            s0[r] += *(const LAS float*)(pb + wc4) + *(const LAS float*)(pp + wc4);
            s1[r] += *(const LAS float*)(pb + wc4 + 128) + *(const LAS float*)(pp + wc4 + 128); }
    }
}


#define FA_SB() __builtin_amdgcn_sched_barrier(0)
__device__ __forceinline__ float tile_max(const f32x16& s0, const f32x16& s1) {
    float ta = fmaxf(fmaxf(s0[0], s0[1]), s1[0]), tb = fmaxf(fmaxf(s0[2], s0[3]), s1[1]);
    ta = fmaxf(fmaxf(ta, s1[2]), s1[3]);
#pragma unroll
    for (int r = 4; r < 16; r += 4) { ta = fmaxf(fmaxf(ta, s0[r]), s0[r + 1]); tb = fmaxf(fmaxf(tb, s0[r + 2]), s0[r + 3]); ta = fmaxf(fmaxf(ta, s1[r]), s1[r + 1]); tb = fmaxf(fmaxf(tb, s1[r + 2]), s1[r + 3]); }
    float tm = fmaxf(ta, tb);
    auto rr = __builtin_amdgcn_permlane32_swap(__builtin_bit_cast(unsigned, tm), __builtin_bit_cast(unsigned, tm), false, false);
    return fmaxf(__builtin_bit_cast(float, rr[0]), __builtin_bit_cast(float, rr[1]));
}
__device__ __forceinline__ void decide(State& st, f32x16& s0, f32x16& s1, float tm, bool first) {
    if (first || __any(tm > THR)) {
        const float dl = first ? tm : fmaxf(tm, 0.f);
        st.m += dl;
        const float al = __builtin_amdgcn_exp2f(-dl);
        st.l *= al;
#pragma unroll
        for (int r = 0; r < 16; ++r) { s0[r] -= dl; s1[r] -= dl; st.o[0][r] *= al; st.o[1][r] *= al; }
    }
}
template <int MIX>
__device__ __forceinline__ void apply_mask(f32x16& s0, f32x16& s1, int hi, int j, int qpos, int rq, int cq, int csq, const LAS unsigned char* lds, int bt_off) {
    if (MIX == 2) {
#pragma unroll
        for (int r = 0; r < 16; ++r) { const int kp = 64 * j + crow(r, hi), d0 = kp - qpos, d1 = kp + 32 - qpos;
            s0[r] = (d0 <= 128 && d0 >= -128) ? s0[r] : NEG; s1[r] = (d1 <= 128 && d1 >= -128) ? s1[r] : NEG; }
    } else if (MIX == 3) {
        const LAS unsigned char* pb = lds + DB_OFF + (j - rq + 7) * 512 + (63 - cq + 4 * hi) * 4;
        const LAS unsigned char* pp = lds + DP_OFF + (48 - csq + 4 * hi) * 4;
#pragma unroll
        for (int r = 0; r < 16; ++r) { const int wc4 = ((r & 3) + 8 * (r >> 2)) * 4;
            s0[r] += *(const LAS float*)(pb + wc4) + *(const LAS float*)(pp + wc4);
            s1[r] += *(const LAS float*)(pb + wc4 + 128) + *(const LAS float*)(pp + wc4 + 128); }
    }
}
template <int MIX, int KS0, int NKS, bool HASNEXT, bool MASKNEXT>
__device__ __forceinline__ void fused_step(State& st, f32x16& c0, f32x16& c1, f32x16& n0, f32x16& n1, float nref, float& ntm,
                                           const LAS unsigned char* Kn, const bf16x8 (&qf)[4], const LAS unsigned char* qlds, const LAS unsigned char* Vb, int vb0, int r32, int hi,
                                           int j, int qpos, int rq, int cq, int csq, const LAS unsigned char* lds, int bt_off) {
    bf16x8 kA0 = {}, kA1 = {}, kB0 = {}, kB1 = {};
#define FA_KLD(kk, X0, X1) do { X0 = *(const LAS bf16x8*)(Kn + (2 * (KS0 + (kk)) + hi) * 1024 + r32 * 16); X1 = *(const LAS bf16x8*)(Kn + (2 * (KS0 + (kk)) + hi) * 1024 + 512 + r32 * 16); } while (0)
    if (HASNEXT) {
        FA_KLD(0, kA0, kA1);
        f32x16 negm;
#pragma unroll
        for (int r = 0; r < 16; ++r) negm[r] = -nref;
        n0 = negm; n1 = negm;
    }
    float ps0 = 0.f, ps1 = 0.f;
    s16x4 va[4], vb[4];
    __builtin_amdgcn_s_setprio(1);
    FA_SB();
#pragma unroll
    for (int g = 0; g < 4; ++g) {
        const bool mm = HASNEXT && (NKS == 4 || (g & 1) == 0);
        const int kk = (NKS == 4) ? g : (g >> 1);
        const bool nextk = HASNEXT && mm && (kk + 1 < NKS);
        bf16x8 qv = {};
        if (mm) { qv = FA_QF(KS0 + kk); n0 = __builtin_amdgcn_mfma_f32_32x32x16_bf16((kk & 1) ? kB0 : kA0, qv, n0, 0, 0, 0); }
        FA_SB();
        if (nextk) { if (kk & 1) FA_KLD(kk + 1, kA0, kA1); else FA_KLD(kk + 1, kB0, kB1); }
#pragma unroll
        for (int i = 0; i < 4; ++i) { c0[4 * g + i] = __builtin_amdgcn_exp2f(c0[4 * g + i]); ps0 += c0[4 * g + i]; }
        FA_SB();
        if (mm) n1 = __builtin_amdgcn_mfma_f32_32x32x16_bf16((kk & 1) ? kB1 : kA1, qv, n1, 0, 0, 0);
        FA_SB();
        if (g == 3) {
#pragma unroll
            for (int q = 0; q < 4; ++q) va[q] = vtr(Vb + vb0 + (q >> 1) * 4096 + (q & 1) * 512);
        }
#pragma unroll
        for (int i = 0; i < 4; ++i) { c1[4 * g + i] = __builtin_amdgcn_exp2f(c1[4 * g + i]); ps1 += c1[4 * g + i]; }
        FA_SB();
    }
#undef FA_KLD
    st.l += ps0 + ps1;
    if (HASNEXT && MASKNEXT) apply_mask<MIX>(n0, n1, hi, j, qpos, rq, cq, csq, lds, bt_off);
    float pm[4] = {0.f, 0.f, 0.f, 0.f};
    FA_SB();
#pragma unroll
    for (int ks = 0; ks < 4; ++ks) {
        const f32x16& sv = (ks >> 1) ? c1 : c0; const int sh = ks & 1;
        v4u pw; pw.x = cvtpk(sv[8 * sh + 0], sv[8 * sh + 1]); pw.y = cvtpk(sv[8 * sh + 2], sv[8 * sh + 3]); pw.z = cvtpk(sv[8 * sh + 4], sv[8 * sh + 5]); pw.w = cvtpk(sv[8 * sh + 6], sv[8 * sh + 7]);
        const bf16x8 pf = __builtin_bit_cast(bf16x8, pw);
        s16x4 (&vc)[4] = (NKS == 2) ? va : ((ks & 1) ? vb : va); s16x4 (&vn)[4] = (ks & 1) ? va : vb;
        if (NKS != 2) { if (ks < 3) {
#pragma unroll
            for (int q = 0; q < 4; ++q) vn[q] = vtr(Vb + vb0 + (q >> 1) * 4096 + (ks + 1) * 1024 + (q & 1) * 512); } }
        else if (ks > 0) {
#pragma unroll
            for (int q = 0; q < 4; ++q) va[q] = vtr(Vb + vb0 + (q >> 1) * 4096 + ks * 1024 + (q & 1) * 512); }
        st.o[0] = __builtin_amdgcn_mfma_f32_32x32x16_bf16((bf16x8){vc[0][0], vc[0][1], vc[0][2], vc[0][3], vc[1][0], vc[1][1], vc[1][2], vc[1][3]}, pf, st.o[0], 0, 0, 0);
        FA_SB();
        float pma = 0.f;
        if (HASNEXT) pma = fmaxf(fmaxf(n0[4 * ks], n0[4 * ks + 1]), fmaxf(n0[4 * ks + 2], n0[4 * ks + 3]));
        FA_SB();
        st.o[1] = __builtin_amdgcn_mfma_f32_32x32x16_bf16((bf16x8){vc[2][0], vc[2][1], vc[2][2], vc[2][3], vc[3][0], vc[3][1], vc[3][2], vc[3][3]}, pf, st.o[1], 0, 0, 0);
        FA_SB();
        if (HASNEXT) pm[ks] = fmaxf(pma, fmaxf(fmaxf(n1[4 * ks], n1[4 * ks + 1]), fmaxf(n1[4 * ks + 2], n1[4 * ks + 3])));
        FA_SB();
    }
    __builtin_amdgcn_s_setprio(0);
    if (HASNEXT) {
        float tm = fmaxf(fmaxf(pm[0], pm[1]), fmaxf(pm[2], pm[3]));
        auto rr = __builtin_amdgcn_permlane32_swap(__builtin_bit_cast(unsigned, tm), __builtin_bit_cast(unsigned, tm), false, false);
        ntm = fmaxf(__builtin_bit_cast(float, rr[0]), __builtin_bit_cast(float, rr[1]));
    }
}

template <int MIX>
__device__ __forceinline__ void attn_unit(Frame& F, int l, int b, int h, int qt, bool isctx) {
    int tid_ = threadIdx.x; asm volatile("" : "+v"(tid_));
    const int tid = tid_, lane = tid & 63, r32 = lane & 31, hi = lane >> 5, wid = __builtin_amdgcn_readfirstlane(tid >> 6);
    const bf16* P = F.p();
    const int kvh = (MIX == 0 || MIX == 2) ? (h >> 1) : h;
    const int qo = QOFF_(MIX) + h * 64, ko = KOFF_(MIX) + kvh * 64, vo = VOFF_(MIX) + kvh * 64;
    const int qbase = isctx ? 0 : qt * 256;
    const int qpos = qbase + wid * 32 + r32;
    const size_t qrow = (size_t)(isctx ? ML + b * LC : b * SEQ) + qpos;
    const float c2 = (MIX == 1 ? 0.17677669529663687f : 0.125f) * LOG2E;
    bf16x8 qf[4];
#pragma unroll
    for (int ks = 0; ks < 4; ++ks) { const v4u raw = *(const v4u*)(P + qrow * PROJ + qo + 16 * ks + 8 * hi);
        v4u sc; sc.x = cvtpk(bflo(raw.x) * c2, bfhi(raw.x) * c2); sc.y = cvtpk(bflo(raw.y) * c2, bfhi(raw.y) * c2); sc.z = cvtpk(bflo(raw.z) * c2, bfhi(raw.z) * c2); sc.w = cvtpk(bflo(raw.w) * c2, bfhi(raw.w) * c2);
        qf[ks] = __builtin_bit_cast(bf16x8, sc); }
    const LAS unsigned char* qlds = F.lds + Q_OFF + wid * 4096 + lane * 16;
    if (MIX == 1) {
#pragma unroll
        for (int ks = 0; ks < 4; ++ks) *(LAS bf16x8*)(F.lds + Q_OFF + wid * 4096 + lane * 16 + ks * 1024) = qf[ks];
    }
    int jlo = 0, jhi = 0;
    if (!isctx) {
        if (MIX == 0 || MIX == 1) { jlo = 0; jhi = 32; }
        if (MIX == 2) { jlo = (qbase - 128) / 64; jlo = jlo < 0 ? 0 : jlo; jhi = (qbase + 256 + 128) / 64; jhi = jhi > 32 ? 32 : jhi; }
        if (MIX == 3) { const int r0 = qbase / 64; int a = r0 - 4; a = a < 0 ? 0 : (a > 24 ? 24 : a); int c = r0 + 3 - 4; c = c < 0 ? 0 : (c > 24 ? 24 : c); jlo = a; jhi = c + 8; }
    }
    const int NT = 4 + (jhi - jlo);
    const LAS unsigned char* lds = F.lds;
    if (MIX == 3 && !isctx) {
        __syncthreads();
        LAS float* bt = (LAS float*)(F.lds + DB_OFF);
        for (int i = tid; i < 15 * 128; i += NTHR) { const int ri = i >> 7, dl = (i & 127) - 63; bt[i] = (dl >= -15 && dl <= 15) ? F.rpb()[((l * 4 + h) * 15 + ri) * 31 + dl + 15] * LOG2E : 0.f; }
        LAS float* pt = (LAS float*)(F.lds + DP_OFF);
        if (tid < 128) pt[tid] = (tid >= 48 && tid < 64) ? 0.f : NEG;
    }
    const size_t crow0 = (size_t)(ML + b * LC), lrow0 = (size_t)b * SEQ;
    const size_t ksrc_off = (size_t)lane * PROJ + ko + wid * 8;
    const size_t vsrc_off = (size_t)(16 * (wid & 3) + (lane >> 2)) * PROJ + vo + (wid >> 2) * 32 + (lane & 3) * 8;
#define FA_TILE_ROW0(t) ((t) < 4 ? crow0 + 64 * (t) : lrow0 + 64 * (size_t)(jlo + (t) - 4))
#define FA_DMA_K(t, slot) __builtin_amdgcn_global_load_lds((const unsigned*)(P + FA_TILE_ROW0(t) * PROJ + ksrc_off), (LAS unsigned*)(F.lds + K_OFF + (slot) * 8192 + wid * 1024), 16, 0, 0)
#define FA_DMA_V(t, slot) __builtin_amdgcn_global_load_lds((const unsigned*)(P + FA_TILE_ROW0(t) * PROJ + vsrc_off), (LAS unsigned*)(F.lds + V_OFF + (slot) * 8192 + wid * 1024), 16, 0, 0)
#define FA_NEED(t) ((MIX == 2 && (t) >= 4) ? ((64 * (jlo + (t) - 4) <= qw0 + 31 + 128) && (64 * (jlo + (t) - 4) + 63 >= qw0 - 128)) : (MIX == 3 && (t) >= 4) ? ((jlo + (t) - 4 >= rsw) && (jlo + (t) - 4 < rsw + 8)) : true)
#define FA_QK(S0, S1, REF, t, slot, KS0, NKS) qk_tile<MIX, KS0, NKS>(S0, S1, REF, lds + K_OFF + (slot) * 8192, qf, qlds, r32, hi, (t) >= 4, jlo + (t) - 4, qpos, rq, cq, csq, lds, BT_OFF)
#define FA_NEXT3(k) ((k) == 2 ? 0 : (k) + 1)
    const int vb0 = ((lane >> 4) & 1) * 32 + (lane & 3) * 8 + (4 * hi + ((lane & 15) >> 2)) * 64;
    State st, st2;
    st.m = 0.f; st.l = 0.f; st.o[0] = f32x16{}; st.o[1] = f32x16{};
    st2.m = 0.f; st2.l = 0.f; st2.o[0] = f32x16{}; st2.o[1] = f32x16{};
    if (MIX == 2) { st.m = F.sink()[l * 4 + h] * LOG2E; st.l = hi == 0 ? 1.f : 0.f; }
    const bool has_ref = (MIX == 2);
    const int qw0 = qbase + wid * 32;
    const int rq = qpos / GRIDW, cq = qpos % GRIDW;
    int csq = cq - 8; csq = csq < 0 ? 0 : (csq > 48 ? 48 : csq);
    int rsw = (qw0 / GRIDW) - 4; rsw = rsw < 0 ? 0 : (rsw > 24 ? 24 : rsw);
    __syncthreads();
    FA_DMA_K(0, 0); FA_DMA_V(0, 0); FA_DMA_K(1, 1);
    asm volatile("s_waitcnt vmcnt(0)" ::: "memory");
    __syncthreads();
    int kq = 0;
#define FA_STEP(KS0, NKS, HASNEXT, MASKNEXT, ST, C0, C1, N0, N1, NREF, NTM, tn, kslot, tv) \
    fused_step<MIX, KS0, NKS, HASNEXT, MASKNEXT>(ST, C0, C1, N0, N1, NREF, NTM, lds + K_OFF + (kslot) * 8192, qf, qlds, lds + V_OFF + ((tv) & 1) * 8192, vb0, r32, hi, jlo + (tn) - 4, qpos, rq, cq, csq, lds, BT_OFF)
    if (MIX == 3) {
        const bool cvt_on = CVT_ATT && (l == 0) && !isctx && F.G == 256;
        LAS unsigned char* cvb = F.lds + (wid < 4 ? Q_OFF + wid * 8192 : DP_OFF + 512 + (wid - 4) * 8192);
        const int cv0 = CVT_N_IN + CVT_N_OUT + (F.bid * NWAVES + wid) * CVT_ATT_PER_WAVE;
        for (int t = 0; t < NT; ++t) {
            asm volatile("s_waitcnt vmcnt(0)" ::: "memory");
            __syncthreads();
            const int k1 = FA_NEXT3(kq), k2 = FA_NEXT3(k1);
            if (t + 2 < NT) FA_DMA_K(t + 2, k2);
            if (t + 1 < NT) FA_DMA_V(t + 1, (t + 1) & 1);
            if (cvt_on && t <= CVT_ATT_PER_WAVE) cvt_att_step(F, cv0, t, cvb, lane);
            if (FA_NEED(t)) {
                f32x16 c0, c1, n0, n1; float ntm = 0.f;
                FA_QK(c0, c1, st.m, t, kq, 0, 4);
                const float ctm = tile_max(c0, c1);
                decide(st, c0, c1, ctm, t == 0);
                FA_STEP(0, 4, false, false, st, c0, c1, n0, n1, 0.f, ntm, t + 1, k1, t);
            }
            kq = k1;
        }
        if (cvt_on && NT <= CVT_ATT_PER_WAVE) { asm volatile("s_waitcnt vmcnt(0)" ::: "memory"); cvt_att_step(F, cv0, CVT_ATT_PER_WAVE, cvb, lane); }
    } else if (MIX != 1) {
        f32x16 c0, c1, n0, n1; float ctm, ntm = 0.f, nref = 0.f; bool cneed = true, nneed = false;
        FA_QK(c0, c1, st.m, 0, 0, 0, 4);
        ctm = tile_max(c0, c1);
        for (int t = 0; t < NT; ++t) {
            asm volatile("s_waitcnt vmcnt(0)" ::: "memory");
            __syncthreads();
            const int k1 = FA_NEXT3(kq), k2 = FA_NEXT3(k1);
            if (t + 2 < NT) FA_DMA_K(t + 2, k2);
            if (t + 1 < NT) FA_DMA_V(t + 1, (t + 1) & 1);
            nneed = (t + 1 < NT) && FA_NEED(t + 1);
            if (cneed) decide(st, c0, c1, ctm, t == 0 && !has_ref);
            nref = st.m;
            if (cneed && nneed) {
                if (MIX != 0 && t + 1 >= 4) FA_STEP(0, 4, true, true, st, c0, c1, n0, n1, nref, ntm, t + 1, k1, t);
                else FA_STEP(0, 4, true, false, st, c0, c1, n0, n1, nref, ntm, t + 1, k1, t);
            } else if (cneed) {
                FA_STEP(0, 4, false, false, st, c0, c1, n0, n1, nref, ntm, t + 1, k1, t);
            } else if (nneed) {
                FA_QK(n0, n1, nref, t + 1, k1, 0, 4); ntm = tile_max(n0, n1);
            }
            c0 = n0; c1 = n1; ctm = ntm; cneed = nneed; kq = k1;
        }
    } else {
        f32x16 a0, a1, b0, b1; float atm, btm = 0.f;
        FA_QK(a0, a1, st.m, 0, 0, 0, 2);
        atm = tile_max(a0, a1);
        for (int t = 0; t < NT; ++t) {
            asm volatile("s_waitcnt vmcnt(0)" ::: "memory");
            __syncthreads();
            const int k1 = FA_NEXT3(kq), k2 = FA_NEXT3(k1);
            if (t + 2 < NT) FA_DMA_K(t + 2, k2);
            if (t + 1 < NT) FA_DMA_V(t + 1, (t + 1) & 1);
            decide(st, a0, a1, atm, t == 0);
            FA_STEP(2, 2, true, false, st, a0, a1, b0, b1, st2.m, btm, t, kq, t);
            decide(st2, b0, b1, btm, t == 0);
            if (t + 1 < NT) FA_STEP(0, 2, true, false, st2, b0, b1, a0, a1, st.m, atm, t + 1, k1, t);
            else FA_STEP(0, 2, false, false, st2, b0, b1, a0, a1, st.m, atm, t + 1, k1, t);
            kq = k1;
        }
    }
#undef FA_STEP
#undef FA_DMA_K
#undef FA_DMA_V
#undef FA_NEED
#undef FA_QK
#undef FA_NEXT3
#undef FA_TILE_ROW0
    const float lt = st.l + __shfl_xor(st.l, 32);
    const float inv = 1.0f / lt;
    bf16* orow = F.o() + qrow * D + MIX * 256 + h * 64;
    unsigned char* orow8 = (unsigned char*)F.o() + qrow * D + MIX * 256 + h * 64;
    if (MIX != 1) {
#pragma unroll
        for (int db = 0; db < 2; ++db)
#pragma unroll
            for (int g = 0; g < 4; ++g) {
                if constexpr ((FP8_GEMMS & 2) != 0) *(unsigned*)(orow8 + 32 * db + 8 * g + 4 * hi) = pk4_fp8(st.o[db][4 * g] * inv, st.o[db][4 * g + 1] * inv, st.o[db][4 * g + 2] * inv, st.o[db][4 * g + 3] * inv, AS_O);
                else { v2u w; w.x = cvtpk(st.o[db][4 * g] * inv, st.o[db][4 * g + 1] * inv); w.y = cvtpk(st.o[db][4 * g + 2] * inv, st.o[db][4 * g + 3] * inv);
                *(v2u*)(orow + 32 * db + 8 * g + 4 * hi) = w; } }
    } else {
        const float lt2 = st2.l + __shfl_xor(st2.l, 32);
        float d1 = 0.f, d2 = 0.f;
        for (int i = 0; i < 32; ++i) { d1 += F.lam_q1()[l * 32 + i] * F.lam_k1()[l * 32 + i]; d2 += F.lam_q2()[l * 32 + i] * F.lam_k2()[l * 32 + i]; }
        const float lam_init = 0.8f - 0.6f * expf(-0.3f * (float)l);
        const float lam = expf(d1) - expf(d2) + lam_init;
        const float i2 = lam / lt2;
        float ss = 0.f;
#pragma unroll
        for (int db = 0; db < 2; ++db)
#pragma unroll
            for (int r = 0; r < 16; ++r) { const float v = st.o[db][r] * inv - st2.o[db][r] * i2; st.o[db][r] = v; ss += v * v; }
        ss += __shfl_xor(ss, 32);
        const float rstd = 1.0f / sqrtf(ss * (1.f / 64.f) + EPS) * (1.f - lam_init);
#pragma unroll
        for (int db = 0; db < 2; ++db)
#pragma unroll
            for (int g = 0; g < 4; ++g) { const int d0 = 32 * db + 8 * g + 4 * hi; const f32x4 sg = *(const f32x4*)(F.subln() + l * 64 + d0);
                if constexpr ((FP8_GEMMS & 2) != 0) *(unsigned*)(orow8 + d0) = pk4_fp8(st.o[db][4 * g] * rstd * sg.x, st.o[db][4 * g + 1] * rstd * sg.y, st.o[db][4 * g + 2] * rstd * sg.z, st.o[db][4 * g + 3] * rstd * sg.w, AS_O);
                else { v2u w; w.x = cvtpk(st.o[db][4 * g] * rstd * sg.x, st.o[db][4 * g + 1] * rstd * sg.y); w.y = cvtpk(st.o[db][4 * g + 2] * rstd * sg.z, st.o[db][4 * g + 3] * rstd * sg.w);
                *(v2u*)(orow + d0) = w; } }
    }
}
}

__device__ __forceinline__ void ph_attn(Frame& F, int l) {
    const int nunits = 1024 + (l == 0 ? 128 : 0);
    for (int it = F.bid; it < nunits; it += F.G) {
        if (it < 1024) { const int mo = it >> 8, r = it & 255, b = r & 7, h = (r >> 3) & 3, qt = r >> 5;
            if (mo == 0) fa::attn_unit<1>(F, l, b, h, qt, false); else if (mo == 1) fa::attn_unit<0>(F, l, b, h, qt, false);
            else if (mo == 2) fa::attn_unit<3>(F, l, b, h, qt, false); else fa::attn_unit<2>(F, l, b, h, qt, false); }
        else { const int r = it - 1024, mix = r >> 5, b = r & 7, h = (r >> 3) & 3;
            if (mix == 0) fa::attn_unit<0>(F, l, b, h, 0, true); else if (mix == 1) fa::attn_unit<1>(F, l, b, h, 0, true);
            else if (mix == 2) fa::attn_unit<2>(F, l, b, h, 0, true); else fa::attn_unit<3>(F, l, b, h, 0, true); }
    }
}

#define ROW_OF(F, it) ((it) < 8 ? ((F).bid & 7) * SEQ + ((F).bid >> 3) * 8 + (F).wave + 256 * (it) : ML + ((F).bid & 7) * LC + ((F).bid >> 3) * 8 + (F).wave)
constexpr int WRS = D + 4;
template <int L>
__device__ __forceinline__ void ph_n2(Frame& F) {
    constexpr int l = L;
    LAS float* wr = (LAS float*)F.lds;
    {
        const float* wsrc = F.w_router() + (size_t)l * D * NE;
        float tv[32];
#pragma unroll
        for (int q = 0; q < 32; ++q) tv[q] = wsrc[F.tid + NTHR * q];
#pragma unroll
        for (int q = 0; q < 32; ++q) { const int i = F.tid + NTHR * q, k = i / NE, e = i % NE; wr[e * WRS + k] = tv[q]; }
    }
    __syncthreads();
    const int nrows = (l == 0) ? MT : ML;
#define N2_LOAD(row_, OPV, XV) do { const bool lat_ = (row_) < ML; \
        const bf16* opr_ = F.opb() + (size_t)(row_) * D; \
        if (L == 0) { const float* xin_ = lat_ ? F.x() + (size_t)(row_) * D : F.ctx() + (size_t)((row_) - ML) * D; \
            _Pragma("unroll") for (int j = 0; j < 4; ++j) { OPV[j] = *(const v2u*)(opr_ + 4 * F.lane + 256 * j); XV[j] = *(const f32x4*)(xin_ + 4 * F.lane + 256 * j); } } \
        else { const bf16* xin_ = F.xb() + (size_t)(row_) * D; \
            _Pragma("unroll") for (int j = 0; j < 4; ++j) { OPV[j] = *(const v2u*)(opr_ + 4 * F.lane + 256 * j); XV##b[j] = *(const v2u*)(xin_ + 4 * F.lane + 256 * j); } } } while (0)
    int row = ROW_OF(F, 0);
    f32x4 pG1[4], pGT[4], pG2[4], pS1[4], pSC[4];
#define N2_PARAMS(mrow_) do { const float* md_ = F.mod() + ((size_t)l * 9 + (mrow_)) * 6144; \
        _Pragma("unroll") for (int j = 0; j < 4; ++j) { const int c0 = 4 * F.lane + 256 * j; pG1[j] = *(const f32x4*)(F.g_post_mix() + l * D + c0); pGT[j] = *(const f32x4*)(md_ + 2048 + c0); \
            pG2[j] = *(const f32x4*)(F.g_pre_ffn() + l * D + c0); pS1[j] = *(const f32x4*)(md_ + 3072 + c0); pSC[j] = *(const f32x4*)(md_ + 4096 + c0); } } while (0)
    N2_PARAMS(F.bid & 7);
    v2u opn[4]; f32x4 xn[4]; v2u xnb[4];
#pragma unroll
    for (int j = 0; j < 4; ++j) { xn[j] = (f32x4){0.f, 0.f, 0.f, 0.f}; xnb[j] = (v2u){0u, 0u}; }
    N2_LOAD(row, opn, xn);
    for (int it = 0; it < 9 && row < nrows; ++it) {
        v2u opc[4]; f32x4 xc[4];
#pragma unroll
        for (int j = 0; j < 4; ++j) { opc[j] = opn[j]; xc[j] = (L == 0) ? xn[j] : (f32x4){bflo(xnb[j].x), bfhi(xnb[j].x), bflo(xnb[j].y), bfhi(xnb[j].y)}; }
        const int nrow = (it + 1 < 9) ? ROW_OF(F, it + 1) : nrows;
        if (nrow < nrows) N2_LOAD(nrow, opn, xn);
        const bool lat = row < ML;
        bf16* xr = F.xb() + (size_t)row * D;
        if (!lat) N2_PARAMS(8);
        f32x4 v[4]; float ss = 0.f;
#pragma unroll
        for (int j = 0; j < 4; ++j) { v[j] = (f32x4){bflo(opc[j].x), bfhi(opc[j].x), bflo(opc[j].y), bfhi(opc[j].y)}; ss += (v[j].x * v[j].x + v[j].y * v[j].y) + (v[j].z * v[j].z + v[j].w * v[j].w); }
        const float rstd = 1.0f / sqrtf(wave_sum(ss) * (1.f / D) + EPS);
#pragma unroll
        for (int j = 0; j < 4; ++j) { const int c0 = 4 * F.lane + 256 * j;
            v[j] = xc[j] + pGT[j] * (v[j] * rstd * pG1[j]);
            v2u xw_; xw_.x = pk2(v[j].x, v[j].y); xw_.y = pk2(v[j].z, v[j].w);
            *(v2u*)(xr + c0) = xw_; }
        float s2 = 0.f;
#pragma unroll
        for (int j = 0; j < 4; ++j) s2 += (v[j].x * v[j].x + v[j].y * v[j].y) + (v[j].z * v[j].z + v[j].w * v[j].w);
        const float rstd2 = 1.0f / sqrtf(wave_sum(s2) * (1.f / D) + EPS);
        float lg[NE];
#pragma unroll
        for (int e = 0; e < NE; ++e) lg[e] = 0.f;
#pragma unroll
        for (int j = 0; j < 4; ++j) { const int c0 = 4 * F.lane + 256 * j;
            const f32x4 hv = (v[j] * rstd2 * pG2[j]) * (1.0f + pSC[j]) + pS1[j];
            if constexpr ((FP8_GEMMS & 4) != 0) *(unsigned*)((unsigned char*)F.h() + (size_t)row * D + c0) = pk4_fp8(hv.x, hv.y, hv.z, hv.w, AS_H);
            else { v2u w; w.x = pk2(hv.x, hv.y); w.y = pk2(hv.z, hv.w);
            *(v2u*)(F.h() + (size_t)row * D + c0) = w; }
            v[j] = hv; }
#pragma unroll
        for (int e = 0; e < NE; ++e) {
#pragma unroll
            for (int j = 0; j < 4; ++j) { const f32x4 ww = *(const LAS f32x4*)(wr + e * WRS + 4 * F.lane + 256 * j); lg[e] += (v[j].x * ww.x + v[j].y * ww.y) + (v[j].z * ww.z + v[j].w * ww.w); }
            if ((e & 3) == 3) asm volatile("" ::: "memory"); }
#pragma unroll
        for (int e = 0; e < NE; ++e) lg[e] = wave_sum(lg[e]);
        float mx = lg[0];
#pragma unroll
        for (int e = 1; e < NE; ++e) mx = fmaxf(mx, lg[e]);
        float se = 0.f;
#pragma unroll
        for (int e = 0; e < NE; ++e) { lg[e] = expf(lg[e] - mx); se += lg[e]; }
        float mine = 0.f;
#pragma unroll
        for (int e = 0; e < NE; ++e) mine = (F.lane == e) ? lg[e] : mine;
        if (F.lane < NE) {
            if (lat) F.affT()[((size_t)(row / SEQ) * NE + F.lane) * SEQ + (row % SEQ)] = mine / se;
            else { const int rc = row - ML; F.affcT()[((size_t)(rc / LC) * NE + F.lane) * LC + (rc % LC)] = mine / se; }
        }
        row = nrow;
    }
#undef N2_LOAD
#undef N2_PARAMS
}

__device__ __forceinline__ void topk_item(Frame& F, const float* vals, int n, int cap, int* slot_tab  , float* gate  , int* rowidx  , int row_base) {
    LAS int* cnt = (LAS int*)F.lds;
    const int tid = F.tid, lane = F.lane, wave = F.wave;
    unsigned k[4] = {0u, 0u, 0u, 0u};
    if (4 * tid < n) { const v4u v = *(const v4u*)(vals + 4 * tid); k[0] = v.x; k[1] = v.y; k[2] = v.z; k[3] = v.w; }
    __syncthreads();
    unsigned T = 0u; int buf = 0;
    for (int bit = 30; bit >= 0; --bit) {
        const unsigned cand = T | (1u << bit);
        const int c = __popcll(__ballot(k[0] >= cand)) + __popcll(__ballot(k[1] >= cand)) + __popcll(__ballot(k[2] >= cand)) + __popcll(__ballot(k[3] >= cand));
        if (lane == 0) cnt[buf * 8 + wave] = c;
        __syncthreads();
        int tot = 0;
#pragma unroll
        for (int w = 0; w < 8; ++w) tot += cnt[buf * 8 + w];
        if (tot >= cap) T = cand;
        buf ^= 1;
    }
    int g[4], q[4], pk = 0;
#pragma unroll
    for (int i = 0; i < 4; ++i) { g[i] = k[i] > T ? 1 : 0; q[i] = k[i] == T ? 1 : 0; pk += (g[i] << 16) | q[i]; }
    int inc = pk;
#pragma unroll
    for (int o = 1; o < 64; o <<= 1) { const int v = __shfl_up(inc, o); if (lane >= o) inc += v; }
    if (lane == 63) cnt[64 + wave] = inc;
    __syncthreads();
    int carry = 0, total = 0;
#pragma unroll
    for (int w = 0; w < 8; ++w) { const int v = cnt[64 + w]; if (w < wave) carry += v; total += v; }
    int before = carry + inc - pk;
    const int need_eq = cap - (total >> 16);
    int gb = before >> 16, eb = before & 0xffff;
#pragma unroll
    for (int i = 0; i < 4; ++i) {
        int sl = -1;
        if (g[i]) sl = gb + (eb < need_eq ? eb : need_eq);
        else if (q[i] && eb < need_eq) sl = gb + eb;
        const int tok = 4 * tid + i;
        if (tok < n) {
            slot_tab[tok] = sl;
            if (sl >= 0) { rowidx[sl] = row_base + tok; gate[sl] = __builtin_bit_cast(float, k[i]); }
        }
        gb += g[i]; eb += q[i];
    }
    __syncthreads();
}
__device__ __forceinline__ void ph_topk(Frame& F, int l) {
    const int nitems = 128 + (l == 0 ? 128 : 0);
    for (int it = F.bid; it < nitems; it += F.G) {
        if (it < 128) { const int b = it & 7, e = it >> 3, be = b * NE + e; const size_t r0 = (size_t)e * ER + b * CAP;
            topk_item(F, F.affT() + (size_t)be * SEQ, SEQ, CAP, F.slot() + (size_t)be * SEQ, F.gate() + r0, F.rowidx() + r0, b * SEQ); }
        else { const int b = it & 7, e = (it - 128) >> 3, be = b * NE + e; const size_t r0 = (size_t)e * ER + NB * CAP + b * CAPC;
            topk_item(F, F.affcT() + (size_t)be * LC, LC, CAPC, F.slotc() + (size_t)be * LC, F.gate() + r0, F.rowidx() + r0, ML + b * LC); }
    }
}

template <int L>
__device__ __forceinline__ void ph_n3(Frame& F) {
    constexpr int l = L;
    const int nrows = (l == 0) ? MT : ML;
#define N3_LOAD(row_, SL, XV) do { const bool lat_ = (row_) < ML; const int rc_ = (row_) - ML; \
        const bf16* xr_ = F.xb() + (size_t)(row_) * D; \
        SL = lat_ ? F.slot()[((size_t)((row_) / SEQ) * NE + (F.lane & 15)) * SEQ + ((row_) % SEQ)] : F.slotc()[((size_t)(rc_ / LC) * NE + (F.lane & 15)) * LC + (rc_ % LC)]; \
        _Pragma("unroll") for (int j = 0; j < 4; ++j) XV[j] = *(const v2u*)(xr_ + 4 * F.lane + 256 * j); } while (0)
    int row = ROW_OF(F, 0);
    {
        LAS float* pl = (LAS float*)F.lds;
        float tv[20];
#pragma unroll
        for (int q = 0; q < 20; ++q) { const int i = F.tid + NTHR * q, set = i / (5 * D), a = (i / D) % 5, c = i % D; const int mrow_ = set ? 8 : (F.bid & 7);
            const float* md_ = F.mod() + ((size_t)l * 9 + mrow_) * 6144; const float* md2_ = F.mod() + ((size_t)(L + 1 < DEPTH ? l + 1 : l) * 9 + mrow_) * 6144;
            tv[q] = a == 0 ? F.g_post_ffn()[l * D + c] : a == 1 ? md_[5120 + c] : a == 2 ? F.g_pre_mix()[(L + 1 < DEPTH ? l + 1 : l) * D + c] : a == 3 ? md2_[c] : md2_[1024 + c]; }
#pragma unroll
        for (int q = 0; q < 20; ++q) pl[F.tid + NTHR * q] = tv[q];
        __syncthreads();
    }
#define N3_P(set, a, j) (*(const LAS f32x4*)((const LAS float*)F.lds + ((set) * 5 + (a)) * D + 4 * F.lane + 256 * (j)))
#define N3_RBASE(row_) ((row_) < ML ? ((row_) / SEQ) * CAP : NB * CAP + (((row_) - ML) / LC) * CAPC)
#define N3_YLOAD(row_, SL, G0, G1, W0, W1, REST) do { unsigned m_ = (unsigned)(__ballot((SL) >= 0) & 0xFFFFull); const int rb_ = N3_RBASE(row_); \
        const bool h0_ = m_ != 0u; const int e0_ = h0_ ? __builtin_ctz(m_) : 0; if (h0_) m_ &= m_ - 1u; \
        const bool h1_ = m_ != 0u; const int e1_ = h1_ ? __builtin_ctz(m_) : 0; if (h1_) m_ &= m_ - 1u; REST = m_; \
        const size_t er0_ = h0_ ? (size_t)e0_ * ER + rb_ + __shfl((SL), e0_) : (size_t)0, er1_ = h1_ ? (size_t)e1_ * ER + rb_ + __shfl((SL), e1_) : er0_; \
        G0 = h0_ ? F.gate()[er0_] : 0.f; G1 = h1_ ? F.gate()[er1_] : 0.f; \
        _Pragma("unroll") for (int j = 0; j < 4; ++j) { W0[j] = *(const v2u*)(F.Y() + er0_ * D + 4 * F.lane + 256 * j); W1[j] = *(const v2u*)(F.Y() + er1_ * D + 4 * F.lane + 256 * j); } } while (0)
    int slA = -1, slB = -1; v2u xA[4], xB[4];
    float g0B = 0.f, g1B = 0.f; v2u w0B[4], w1B[4]; unsigned restB = 0u;
#pragma unroll
    for (int j = 0; j < 4; ++j) { xA[j] = (v2u){0u, 0u}; xB[j] = (v2u){0u, 0u}; w0B[j] = (v2u){0u, 0u}; w1B[j] = (v2u){0u, 0u}; }
    const int row1 = ROW_OF(F, 1);
    N3_LOAD(row, slB, xB);
    if (row1 < nrows) N3_LOAD(row1, slA, xA);
    N3_YLOAD(row, slB, g0B, g1B, w0B, w1B, restB);
#pragma unroll 1
    for (int it = 0; it < 9 && row < nrows; ++it) {
        const int sl = slB; v2u xc[4], w0[4], w1[4]; const float g0 = g0B, g1 = g1B; unsigned msk = restB;
#pragma unroll
        for (int j = 0; j < 4; ++j) { xc[j] = xB[j]; w0[j] = w0B[j]; w1[j] = w1B[j]; }
        const int nrow = (it + 1 < 9) ? ROW_OF(F, it + 1) : nrows, nnrow = (it + 2 < 9) ? ROW_OF(F, it + 2) : nrows;
        slB = slA;
#pragma unroll
        for (int j = 0; j < 4; ++j) xB[j] = xA[j];
        if (nrow < nrows) N3_YLOAD(nrow, slB, g0B, g1B, w0B, w1B, restB);
        if (nnrow < nrows) N3_LOAD(nnrow, slA, xA);
        const bool lat = row < ML; const int pset = lat ? 0 : 1;
        const int rbase = N3_RBASE(row);
        f32x4 y[4];
#pragma unroll
        for (int j = 0; j < 4; ++j) {
            y[j].x = g0 * bflo(w0[j].x) + g1 * bflo(w1[j].x); y[j].y = g0 * bfhi(w0[j].x) + g1 * bfhi(w1[j].x);
            y[j].z = g0 * bflo(w0[j].y) + g1 * bflo(w1[j].y); y[j].w = g0 * bfhi(w0[j].y) + g1 * bfhi(w1[j].y); }
        while (msk) {
            const int e0 = __builtin_ctz(msk); msk &= msk - 1u;
            const int e1 = msk ? __builtin_ctz(msk) : -1; if (e1 >= 0) msk &= msk - 1u;
            const size_t er0 = (size_t)e0 * ER + rbase + __shfl(sl, e0);
            const size_t er1 = e1 >= 0 ? (size_t)e1 * ER + rbase + __shfl(sl, e1) : er0;
            const float h0 = F.gate()[er0], h1 = e1 >= 0 ? F.gate()[er1] : 0.f;
            v2u u0[4], u1[4];
#pragma unroll
            for (int j = 0; j < 4; ++j) { u0[j] = *(const v2u*)(F.Y() + er0 * D + 4 * F.lane + 256 * j); u1[j] = *(const v2u*)(F.Y() + er1 * D + 4 * F.lane + 256 * j); }
#pragma unroll
            for (int j = 0; j < 4; ++j) {
                y[j].x += h0 * bflo(u0[j].x) + h1 * bflo(u1[j].x); y[j].y += h0 * bfhi(u0[j].x) + h1 * bfhi(u1[j].x);
                y[j].z += h0 * bflo(u0[j].y) + h1 * bflo(u1[j].y); y[j].w += h0 * bfhi(u0[j].y) + h1 * bfhi(u1[j].y); }
        }
        float ss = 0.f;
#pragma unroll
        for (int j = 0; j < 4; ++j) ss += (y[j].x * y[j].x + y[j].y * y[j].y) + (y[j].z * y[j].z + y[j].w * y[j].w);
        const float rstd = 1.0f / sqrtf(wave_sum(ss) * (1.f / D) + EPS);
        f32x4 v[4];
#pragma unroll
        for (int j = 0; j < 4; ++j) { const int c0 = 4 * F.lane + 256 * j;
            v[j] = (f32x4){bflo(xc[j].x), bfhi(xc[j].x), bflo(xc[j].y), bfhi(xc[j].y)} + N3_P(pset, 1, j) * (y[j] * rstd * N3_P(pset, 0, j));
            if (L + 1 < DEPTH) { v2u xw_; xw_.x = pk2(v[j].x, v[j].y); xw_.y = pk2(v[j].z, v[j].w); *(v2u*)(F.xb() + (size_t)row * D + c0) = xw_; }
            else *(f32x4*)(F.out() + (size_t)row * D + c0) = v[j]; }
        if (L + 1 < DEPTH) {
            float s2 = 0.f;
#pragma unroll
            for (int j = 0; j < 4; ++j) s2 += (v[j].x * v[j].x + v[j].y * v[j].y) + (v[j].z * v[j].z + v[j].w * v[j].w);
            const float rstd2 = 1.0f / sqrtf(wave_sum(s2) * (1.f / D) + EPS);
#pragma unroll
            for (int j = 0; j < 4; ++j) { const f32x4 o = (v[j] * rstd2 * N3_P(pset, 2, j)) * (1.0f + N3_P(pset, 4, j)) + N3_P(pset, 3, j);
                if constexpr ((FP8_GEMMS & 1) != 0) *(unsigned*)((unsigned char*)F.h() + (size_t)row * D + 4 * F.lane + 256 * j) = pk4_fp8(o.x, o.y, o.z, o.w, AS_H);
                else { v2u w; w.x = pk2(o.x, o.y); w.y = pk2(o.z, o.w);
                *(v2u*)(F.h() + (size_t)row * D + 4 * F.lane + 256 * j) = w; } }
        }
        row = nrow;
    }
#undef N3_YLOAD
#undef N3_RBASE
#undef N3_LOAD
#undef N3_P
}

constexpr int NPHASE = 2 + 9 * DEPTH;

__global__ void __launch_bounds__(NTHR, 2) fwd_kernel(Args args) {
    extern __shared__ __attribute__((aligned(16))) unsigned char lds[];
    Frame F;
    F.lds = (LAS unsigned char*)lds;
    F.tid = threadIdx.x; F.lane = F.tid & 63; F.wave = __builtin_amdgcn_readfirstlane(F.tid >> 6);
    F.G = gridDim.x; F.bid = blockIdx.x;
    unsigned char* ws = args.ws;
    for (int u = F.tid; u < (LDS_BYTES - LDSCTL_OFF) / 4; u += NTHR) ((LAS unsigned*)(F.lds + LDSCTL_OFF))[u] = 0u;
    __syncthreads();
    volatile LAS unsigned* MISC = (volatile LAS unsigned*)(F.lds + MISC_OFF);
    XcdBarrier bar; bar.bar = (unsigned*)(ws + WS_CTL) + 4096; bar.x = 0; bar.st = nullptr;
    const int lo = args.ph_lo, hi = args.ph_hi;
    if (hi - lo > 1) bar = xcd_barrier_post((unsigned*)(ws + WS_CTL) + 4096, MISC + 8);
    if (hi - lo > 1 && threadIdx.x == 0) { const unsigned x_ = xb_xcc_id(); MISC[12] = xb_add((unsigned*)(ws + WS_CTL) + 8192 + 64 * x_, 1u); MISC[13] = x_; }

#ifndef PHSEL
#define PHSEL(k) true
#endif
#ifndef REP_PRO
#define REP_PRO 1
#define REP_QKV 1
#define REP_ATT 1
#define REP_OUT 1
#define REP_TOPK 1
#define REP_GU 1
#define REP_DN 1
#endif
    for (int ph = lo; ph < hi; ++ph) {
        { const CAS Args* kp = (const CAS Args*)__builtin_amdgcn_kernarg_segment_ptr(); asm volatile("" : "+s"(kp)); F.ka = kp;
          int t_ = threadIdx.x, b_ = (MISC[14] != 0u) ? (int)(MISC[13] + 8u * MISC[12]) : (int)blockIdx.x, g_ = gridDim.x; b_ = __builtin_amdgcn_readfirstlane(b_); asm volatile("" : "+v"(t_), "+s"(b_), "+s"(g_));
          F.tid = t_; F.lane = t_ & 63; F.wave = __builtin_amdgcn_readfirstlane(t_ >> 6); F.bid = b_; F.G = g_; }
        if (ph == 0) { if (PHSEL(100)) for (int rep = 0; rep < REP_PRO; ++rep) { ph_prologue(F); __syncthreads(); } }
        else if (ph == 1) { if (PHSEL(101)) ph_norm1(F, 0); }
        else {
            const int l = (ph - 2) / 9, s = (ph - 2) % 9;
            if (PHSEL(s)) switch (s) {
#if NAIVE_GEMM
            case 0: { EpiNBf16 E{F.p(), PROJ}; gemm_naive(F, F.h(), F.win_t() + (size_t)l * PROJ * D, MT, PROJ, 0, 0, 0, E); } break;
            case 1: ph_prep(F, l); break;
            case 2: ph_attn_naive(F, l); break;
            case 3: { EpiNF32 E{F.op(), D}; gemm_naive(F, F.o(), F.wout_t() + (size_t)l * D * D, l == 0 ? MT : ML, D, 0, 0, 0, E); } break;
            case 4: if (l == 0) ph_n2<0>(F); else ph_n2<1>(F); break;
            case 5: ph_topk(F, l); break;
            case 6: { EpiNGateUp E{F.act()}; gemm_naive(F, F.xe(), F.wgu_t() + (size_t)l * NE * 2048 * D, NE * ER, 2048, ER, (size_t)2048 * D, l == 0 ? ER : NB * CAP, E); } break;
            case 7: { EpiNBf16 E{F.Y(), D}; gemm_naive(F, F.act(), F.wdn_t() + (size_t)l * NE * D * D, NE * ER, D, ER, (size_t)D * D, l == 0 ? ER : NB * CAP, E); } break;
#else
            case 0: for (int rep = 0; rep < REP_QKV; ++rep) { constexpr bool F8 = (FP8_GEMMS & 1) != 0;
                      pg8::Gemm g{F.h(), F.win_t() + (size_t)l * PROJ * D, MT, PROJ, F8 ? D / 2 : D, 0, 0, nullptr, F8 ? 1.f / (AS_H * WS8) : 1.f}; pg8::BatchOrder S; S.init(MT, PROJ, F.bid);
                      pg8::EpiQKV E{F.p(), F.cosA(), F.sinA(), F.cosB(), F.sinB(), F.q_gain_a() + l * 64, F.k_gain_a() + l * 64, ML, SEQ, PROJ}; pg8::gemm_phase<pg8::EpiQKV, pg8::BatchOrder, true, true, false, F8>(F.lds, g, S, E); } break;
            case 1: break;
#if NAIVE_ATTN
            case 2: ph_attn_naive(F, l); break;
#else
            case 2: for (int rep = 0; rep < REP_ATT; ++rep) ph_attn(F, l); break;
#endif
            case 3: for (int rep = 0; rep < REP_OUT; ++rep) { const int M = (l == 0) ? MT : ML; constexpr bool F8 = (FP8_GEMMS & 2) != 0;
                      pg8::Gemm g{F.o(), F.wout_t() + (size_t)l * D * D, M, D, F8 ? D / 2 : D, 0, 0, nullptr, F8 ? 1.f / (AS_O * WS8) : 1.f}; pg8::BatchOrder S; S.init(M, D, F.bid);
                      pg8::EpiBf16 E{F.opb(), D}; pg8::gemm_phase<pg8::EpiBf16, pg8::BatchOrder, true, true, false, F8>(F.lds, g, S, E); } break;
            case 4: if (l == 0) ph_n2<0>(F); else ph_n2<1>(F); break;
            case 5: for (int rep = 0; rep < REP_TOPK; ++rep) ph_topk(F, l); break;
            case 6: for (int rep = 0; rep < REP_GU; ++rep) { constexpr bool F8 = (FP8_GEMMS & 4) != 0, O8 = (FP8_GEMMS & 8) != 0;
                      pg8::Gemm g{F.h(), F.wgu_t() + (size_t)l * NE * 2048 * D, NE * ER, 2048, F8 ? D / 2 : D, ER / 256, (size_t)2048 * D * 2, F.rowidx(), F8 ? 1.f / (AS_H * WS8) : 1.f}; pg8::GroupedOrder S; S.init(NE, ER / 256, l == 0 ? 9 : 8, 8, F.G, F.bid); S.pn_fast = true;
                      pg8::EpiGateUpT<O8> E{F.act(), D}; pg8::gemm_phase<pg8::EpiGateUpT<O8>, pg8::GroupedOrder, true, true, true, F8>(F.lds, g, S, E); } break;
            case 7: for (int rep = 0; rep < REP_DN; ++rep) { constexpr bool F8 = (FP8_GEMMS & 8) != 0;
                      pg8::Gemm g{F.act(), F.wdn_t() + (size_t)l * NE * D * D, NE * ER, D, F8 ? D / 2 : D, ER / 256, (size_t)D * D * 2, nullptr, F8 ? 1.f / (AS_ACT * WS8) : 1.f}; pg8::GroupedOrder S; S.init(NE, ER / 256, l == 0 ? 9 : 8, 4, F.G, F.bid);
                      pg8::EpiBf16 E{F.Y(), D}; pg8::gemm_phase<pg8::EpiBf16, pg8::GroupedOrder, true, true, false, F8>(F.lds, g, S, E); } break;
#endif
            case 8: if (l == 0) ph_n3<0>(F); else ph_n3<1>(F); break;
            }
        }
        {
            int cb = 0, ce = 0, cs = 0, cst = 1;
            if (ph == 0) { cb = 0; ce = CVT_ATT ? CVT_N_IN + CVT_N_OUT : CVT_N0; cs = F.bid * NWAVES + F.wave; cst = F.G * NWAVES; }
            else if (ph == 2 + 0 && (F.bid >> 3) >= 26) {
                cb = CVT_N0; ce = CVT_A; cs = ((F.bid & 7) * 6 + (F.bid >> 3) - 26) * NWAVES + F.wave; cst = CVT_W_QKV; }
            else if (ph == 2 + 3 && (F.bid >> 3) >= 4) {
                cb = CVT_A; ce = CVT_B; cs = ((F.bid & 7) * 28 + (F.bid >> 3) - 4) * NWAVES + F.wave; cst = CVT_W_OUT; }
            else if (ph == 2 + 6 && F.bid >= 128) {
                cb = CVT_B; ce = CVT_C; cs = (F.bid - 128) * NWAVES + F.wave; cst = CVT_W_GU; }
            else if (ph == 2 + 7 && F.bid >= 64) {
                cb = CVT_C; ce = CVT_NT; cs = (F.bid - 64) * NWAVES + F.wave; cst = CVT_W_DN; }
            if (ce > cb) { __syncthreads(); convert_items(F, cb, ce, cs, cst); }
        }
        if (ph + 1 < hi && !(ph >= 2 && (ph - 2) % 9 == 1)) {
            const bool need_grid = (MISC[14] == 0u) || ph == 0 || (ph >= 2 && ((ph - 2) % 9 == 5 || (ph - 2) % 9 == 7 || (ph - 2) % 9 == 8));
            __syncthreads(); xcd_barrier(bar, need_grid);
            if (ph == 0) {
                if (threadIdx.x == 0) { bool ok = (gridDim.x == 256);
                    for (int j = 0; j < 16; ++j) { const unsigned c_ = xb_ld((unsigned*)(ws + WS_CTL) + 4096 + XB_XCNT(j)); ok = ok && (c_ == (j < 8 ? 32u : 0u)); }
                    MISC[14] = ok ? 1u : 0u; }
                __syncthreads();
            }
        }
    }
}

extern "C" void kernel_launch(void* const* d_in, const int* in_sizes, int n_in, void* d_out, int out_size, void* d_ws, size_t ws_size, hipStream_t stream) {
    static int grid = 0;
    if (grid == 0) {
        if (n_in != 25 || out_size != ML * D || ws_size < WS_END) { fprintf(stderr, "kernel_launch: unexpected shapes (n_in %d, out %d, ws %zu)\n", n_in, out_size, ws_size); grid = -1; return; }
        int dev = 0, cus = 0;
        if (hipGetDevice(&dev) != hipSuccess || hipDeviceGetAttribute(&cus, hipDeviceAttributeMultiprocessorCount, dev) != hipSuccess) { grid = -1; return; }
        if (hipFuncSetAttribute((const void*)fwd_kernel, hipFuncAttributeMaxDynamicSharedMemorySize, LDS_BYTES) != hipSuccess) { fprintf(stderr, "kernel_launch: hipFuncSetAttribute failed\n"); grid = -1; return; }
        (void)hipGetLastError();
        grid = cus;
        if (grid != 256) { fprintf(stderr, "kernel_launch: built for a 256-CU device (got %d)\n", cus); grid = -1; return; }
    }
    if (grid < 0) return;
    (void)hipMemsetAsync((char*)d_ws + WS_CTL, 0, CTL_ZERO_BYTES, stream);
    Args a{};
    for (int i = 0; i < 25; ++i) a.in[i] = (const float*)d_in[i];
    a.out = (float*)d_out; a.ws = (unsigned char*)d_ws;
#if MK_ONE_LAUNCH
    a.ph_lo = 0; a.ph_hi = NPHASE;
    hipLaunchKernelGGL(fwd_kernel, dim3(grid), dim3(NTHR), LDS_BYTES, stream, a);
#else
    for (int ph = 0; ph < NPHASE; ++ph) { a.ph_lo = ph; a.ph_hi = ph + 1; hipLaunchKernelGGL(fwd_kernel, dim3(grid), dim3(NTHR), LDS_BYTES, stream, a); }
#endif
}
```

```cpp
#include <hip/hip_runtime.h>
#include <cstdio>
#include <cstdint>

#ifndef MK_ONE_LAUNCH
#define MK_ONE_LAUNCH 1
#endif
#ifndef NAIVE_GEMM
#define NAIVE_GEMM 0
#endif
#ifndef NAIVE_ATTN
#define NAIVE_ATTN 0
#endif

#define LAS __attribute__((address_space(3)))
#define GAS __attribute__((address_space(1)))
typedef unsigned short bf16;
typedef unsigned v4u __attribute__((ext_vector_type(4)));
typedef unsigned v2u __attribute__((ext_vector_type(2)));
typedef float f32x4 __attribute__((ext_vector_type(4)));
typedef short bf16x8 __attribute__((ext_vector_type(8)));

constexpr int D = 1024, NB = 8, SEQ = 2048, LC = 256, DEPTH = 2, GRIDW = 64;
constexpr int ML = NB * SEQ, MC = NB * LC, MT = ML + MC;
constexpr int PROJ = 2560, NE = 16, CAP = 256, CAPC = 32, ER = NB * CAP + NB * CAPC;
constexpr float EPS = 1e-6f;
constexpr int NWAVES = 8, NTHR = 512;
__host__ __device__ constexpr int QOFF_(int m) { return m == 0 ? 0 : m == 1 ? 512 : m == 2 ? 1280 : 1792; }
__host__ __device__ constexpr int KOFF_(int m) { return m == 0 ? 256 : m == 1 ? 768 : m == 2 ? 1536 : 2048; }
__host__ __device__ constexpr int VOFF_(int m) { return m == 0 ? 384 : m == 1 ? 1024 : m == 2 ? 1664 : 2304; }

constexpr size_t MiB = 1u << 20;
constexpr size_t WS_CTL = 0, CTL_ZERO_BYTES = 1 * MiB;
constexpr size_t WS_MOD = 1 * MiB;
constexpr size_t WS_ROPE = 2 * MiB;
constexpr size_t WS_AFF = 3 * MiB;
constexpr size_t WS_SLOT = 5 * MiB;
constexpr size_t WS_GATE = 7 * MiB;
constexpr size_t WS_XC = 8 * MiB;
constexpr size_t WS_WIN = 16 * MiB;
constexpr size_t WS_WOUT = 26 * MiB;
constexpr size_t WS_WGU = 32 * MiB;
constexpr size_t WS_WDN = 160 * MiB;
constexpr size_t WS_H = 224 * MiB;
constexpr size_t WS_O = 260 * MiB;
constexpr size_t WS_P = 296 * MiB;
constexpr size_t WS_ACT = 386 * MiB;
constexpr size_t WS_XB = 458 * MiB;
constexpr size_t WS_END = 494 * MiB;

constexpr int RING_BYTES = 131072;
constexpr int LDSCTL_OFF = RING_BYTES, MISC_OFF = LDSCTL_OFF + 320;
constexpr int LDS_BYTES = 147456;

#define RLX_AGENT __ATOMIC_RELAXED, __HIP_MEMORY_SCOPE_AGENT
#define LDS_WAIT() asm volatile("s_waitcnt lgkmcnt(0)" ::: "memory")
#define VM_WAIT() asm volatile("s_waitcnt vmcnt(0)" ::: "memory")
__device__ __forceinline__ unsigned f2bf(float f) { unsigned u = __builtin_bit_cast(unsigned, f); return (u + 0x7fffu + ((u >> 16) & 1u)) >> 16; }
__device__ __forceinline__ unsigned pk2(float lo, float hi) { return f2bf(lo) | (f2bf(hi) << 16); }
#ifndef FP8_GEMMS
#define FP8_GEMMS 15
#endif
constexpr float WS8 = 64.f, AS_H = 8.f, AS_O = 32.f, AS_ACT = 8.f;
__device__ __forceinline__ unsigned pk4_fp8(float a, float b, float c, float d, float s) {
    a = __builtin_amdgcn_fmed3f(a * s, -448.f, 448.f); b = __builtin_amdgcn_fmed3f(b * s, -448.f, 448.f); c = __builtin_amdgcn_fmed3f(c * s, -448.f, 448.f); d = __builtin_amdgcn_fmed3f(d * s, -448.f, 448.f);
    int r = __builtin_amdgcn_cvt_pk_fp8_f32(a, b, 0, false); r = __builtin_amdgcn_cvt_pk_fp8_f32(c, d, r, true); return (unsigned)r;
}
__device__ __forceinline__ float bflo(unsigned u) { return __builtin_bit_cast(float, u << 16); }
__device__ __forceinline__ float bfhi(unsigned u) { return __builtin_bit_cast(float, u & 0xffff0000u); }
__device__ __forceinline__ float bf2f(bf16 u) { return __builtin_bit_cast(float, (unsigned)u << 16); }
#define DPP_ADD(v, ctrl, row_mask) ((v) + __builtin_bit_cast(float, __builtin_amdgcn_update_dpp(0, __builtin_bit_cast(int, (v)), (ctrl), (row_mask), 0xF, false)))
__device__ __forceinline__ float wave_sum(float v) {
    v = DPP_ADD(v, 0x128, 0xF);
    v = DPP_ADD(v, 0x124, 0xF);
    v = DPP_ADD(v, 0x122, 0xF);
    v = DPP_ADD(v, 0x121, 0xF);
    v = DPP_ADD(v, 0x142, 0xA);
    v = DPP_ADD(v, 0x143, 0xC);
    return __builtin_bit_cast(float, __builtin_amdgcn_readlane(__builtin_bit_cast(int, v), 63));
}
__device__ __forceinline__ void ld8(const bf16* p, float* f) {
    const v4u v = *(const v4u*)p;
    f[0] = bflo(v.x); f[1] = bfhi(v.x); f[2] = bflo(v.y); f[3] = bfhi(v.y); f[4] = bflo(v.z); f[5] = bfhi(v.z); f[6] = bflo(v.w); f[7] = bfhi(v.w);
}

#define XB_TMO      128
#define XB_XCNT(j)  (256  + 64 * (j))
#define XB_XSUB(j)  (1280 + 64 * (j))
#define XB_XGEN(j)  (2304 + 64 * (j))
#define XB_TOP      3328
#define XB_TOPGEN   3392
#define XCD_BAR_WORDS 3456
#define XB_SPIN_CAP (1u << 24)
__device__ __forceinline__ unsigned xb_ld(unsigned* p)              { return __hip_atomic_load(p, __ATOMIC_RELAXED, __HIP_MEMORY_SCOPE_AGENT); }
__device__ __forceinline__ unsigned xb_add(unsigned* p, unsigned v) { return __hip_atomic_fetch_add(p, v, __ATOMIC_RELAXED, __HIP_MEMORY_SCOPE_AGENT); }
__device__ __forceinline__ unsigned xb_xcc_id() { return (unsigned)__builtin_amdgcn_s_getreg((3 << 11) | 20) & 0xFu; }
#define XB_SPIN(cond, bar) do { unsigned _sp = 0; while (cond) { __builtin_amdgcn_s_sleep(1); \
    if ((++_sp & 255u) == 0u) { if (xb_ld(&(bar)[XB_TMO])) break; if (_sp > XB_SPIN_CAP) { atomicAdd(&(bar)[XB_TMO], 1u); break; } } } } while (0)
struct XcdBarrier { unsigned* bar; unsigned x; volatile LAS unsigned* st; };
__device__ __forceinline__ XcdBarrier xcd_barrier_post(unsigned* bar, volatile LAS unsigned* st) {
    XcdBarrier b; b.bar = bar; b.x = xb_xcc_id(); b.st = st;
    if (threadIdx.x == 0) (void)xb_add(&bar[XB_XCNT(b.x)], 1u);
    return b;
}
__device__ __forceinline__ void xcd_barrier_complete(unsigned* bar, unsigned x, unsigned& nloc, unsigned& nx) {
    const unsigned G = gridDim.x * gridDim.y * gridDim.z;
    unsigned sum, cnt, mine, sp = 0u;
    for (;;) {
        sum = 0u; cnt = 0u; mine = 0u;
#pragma unroll
        for (unsigned j = 0; j < 16; ++j) { const unsigned c = xb_ld(&bar[XB_XCNT(j)]); sum += c; cnt += (c > 0u) ? 1u : 0u; mine = (j == x) ? c : mine; }
        if (sum == G) break;
        __builtin_amdgcn_s_sleep(1);
        if ((++sp & 255u) == 0u) { if (xb_ld(&bar[XB_TMO])) break; if (sp > XB_SPIN_CAP) { atomicAdd(&bar[XB_TMO], 1u); break; } }
    }
    nloc = mine > 0u ? mine : 1u; nx = cnt > 0u ? cnt : 1u;
}
__device__ __forceinline__ void xcd_barrier(const XcdBarrier& b, bool grid = true) {
    asm volatile("s_waitcnt vmcnt(0)" ::: "memory");
    __syncthreads();
    if (threadIdx.x == 0) {
        unsigned* bar = b.bar;
        __builtin_amdgcn_s_waitcnt(0);
        unsigned nloc = b.st[0], nx = b.st[1];
        if (nloc == 0u) { xcd_barrier_complete(bar, b.x, nloc, nx); b.st[0] = nloc; b.st[1] = nx; }
        const unsigned old = xb_add(&bar[XB_XSUB(b.x)], 1u);
        const unsigned gen = old / nloc;
        if (old + 1u == (gen + 1u) * nloc) {
            if (grid) {
            __builtin_amdgcn_fence(__ATOMIC_RELEASE, "agent");
            asm volatile("s_waitcnt vmcnt(0)" ::: "memory");
            const unsigned og = xb_add(&bar[XB_TOP], 1u);
            const unsigned tg = og / nx;
            if (og + 1u == (tg + 1u) * nx) xb_add(&bar[XB_TOPGEN], 1u);
            else XB_SPIN(xb_ld(&bar[XB_TOPGEN]) == tg, bar);
            }
            __builtin_amdgcn_fence(__ATOMIC_ACQUIRE, "agent");
            xb_add(&bar[XB_XGEN(b.x)], 1u);
            asm volatile("s_waitcnt vmcnt(0)" ::: "memory");
        } else {
            XB_SPIN(xb_ld(&bar[XB_XGEN(b.x)]) == gen, bar);
            __builtin_amdgcn_fence(__ATOMIC_ACQUIRE, "agent");
            asm volatile("s_waitcnt vmcnt(0)" ::: "memory");
        }
    }
    __syncthreads();
}

namespace pg8 {
#define PG8_LAS __attribute__((address_space(3)))
typedef unsigned short bf16_t;
typedef short bf16x8 __attribute__((ext_vector_type(8)));
typedef float f32x4 __attribute__((ext_vector_type(4)));
typedef unsigned u32x4 __attribute__((ext_vector_type(4)));
constexpr int BM = 256, BK = 64, HALF = 128, HTB = HALF * BK * 2  , STAGE_BYTES = 8 * HTB, NXCD = 8, WGM = 8;

__host__ __device__ __forceinline__ int lds_byte(int r, int c) { const int st = (r >> 4) * 2 + (c >> 5), rr = r & 15, cc = c & 31, ob = rr * 64 + cc * 2; return st * 1024 + (ob ^ (((ob >> 9) & 1) << 5)); }
__host__ __device__ __forceinline__ void stage_rc(int b, int& R, int& C) { const int st = b / 1024, sb = b % 1024, swz = sb ^ (((sb >> 9) & 1) << 5); R = (st >> 1) * 16 + swz / 64; C = (st & 1) * 32 + (swz % 64) / 2; }
__host__ __device__ __forceinline__ int perm32(int rho) { const int n = rho >> 4, i = rho & 15; return 8 * (i >> 2) + 4 * n + (i & 3); }

struct Unit { int pm, pn; };
struct Gemm { const bf16_t* A; const bf16_t* Bt; int M, N, K; int tiles_per_group; size_t group_bytes; const int* gather; float dq = 1.f; };
__device__ __forceinline__ const char* gemm_bbase(const Gemm& g, const Unit& u, size_t tstep) { return (const char*)g.Bt + (g.tiles_per_group ? (size_t)(u.pm / g.tiles_per_group) * g.group_bytes : (size_t)0) + (size_t)u.pn * tstep; }

struct StaticOrder {
    int nM, nN, nwg, G, c;
    __host__ __device__ void init(int M, int N, int G_, int c_) { nM = M / BM; nN = N / BM; nwg = nM * nN; G = G_; c = c_; }
    __host__ __device__ bool next(int i, Unit& u) const {
        const long L = (long)i * G + c; if (L >= nwg) return false;
        int wgid = (int)L; { const int q = nwg / NXCD, r = nwg % NXCD, xcd = wgid % NXCD, off = wgid / NXCD; wgid = (xcd < r ? xcd * (q + 1) : r * (q + 1) + (xcd - r) * q) + off; }
        const int nig = WGM * nN, gid = wgid / nig, fm = gid * WGM, gsz = (nM - fm) < WGM ? (nM - fm) : WGM;
        u.pm = fm + ((wgid % nig) % gsz); u.pn = (wgid % nig) / gsz; return true;
    }
    __device__ __forceinline__ void a_ready(const Unit&) const {}
    __device__ __forceinline__ void done(const Unit&) const {}
};


__device__ __forceinline__ unsigned cvt_pk_bf16(float lo, float hi) { unsigned r; asm volatile("v_cvt_pk_bf16_f32 %0, %1, %2" : "=v"(r) : "v"(lo), "v"(hi)); return r; }
struct EpiF32 {
    static constexpr bool PERM = false, AFTER_DRAIN = false;
    float* C; int ldc;
    __device__ __forceinline__ void operator()(const f32x4 (&acc)[2][2][4][2], const Unit& u, int wr, int wc, int fr, int fq) const {
        const int row0 = u.pm * BM + wr * 64 + fr, col0 = u.pn * BM + wc * 32 + 4 * fq;
#pragma unroll
        for (int ai = 0; ai < 2; ++ai)
#pragma unroll
            for (int m = 0; m < 4; ++m) { float* rowp = C + (size_t)(row0 + ai * HALF + m * 16) * ldc + col0;
#pragma unroll
                for (int bj = 0; bj < 2; ++bj)
#pragma unroll
                    for (int n = 0; n < 2; ++n) *(f32x4*)(rowp + bj * HALF + n * 16) = acc[ai][bj][m][n]; }
    }
};
struct EpiBf16 {
    static constexpr bool PERM = true, AFTER_DRAIN = false;
    bf16_t* O; int ldc;
    __device__ __forceinline__ void operator()(const f32x4 (&acc)[2][2][4][2], const Unit& u, int wr, int wc, int fr, int fq) const {
        const int row0 = u.pm * BM + wr * 64 + fr, col0 = u.pn * BM + wc * 32 + 8 * fq;
#pragma unroll
        for (int ai = 0; ai < 2; ++ai)
#pragma unroll
            for (int m = 0; m < 4; ++m) { bf16_t* rowp = O + (size_t)(row0 + ai * HALF + m * 16) * ldc + col0;
#pragma unroll
                for (int bj = 0; bj < 2; ++bj) { const f32x4 v0 = acc[ai][bj][m][0], v1 = acc[ai][bj][m][1];
                    u32x4 w; w.x = cvt_pk_bf16(v0[0], v0[1]); w.y = cvt_pk_bf16(v0[2], v0[3]); w.z = cvt_pk_bf16(v1[0], v1[1]); w.w = cvt_pk_bf16(v1[2], v1[3]);
                    *(u32x4*)(rowp + bj * HALF) = w; } }
    }
};
struct EpiQKV {
    static constexpr bool PERM = true, AFTER_DRAIN = false;
    bf16_t* O; const float *cosA, *sinA, *cosB, *sinB, *qg, *kg; int n_lat_rows, seq, ldc;
    __device__ __forceinline__ void operator()(const f32x4 (&acc)[2][2][4][2], const Unit& u, int wr, int wc, int fr, int fq) const {
        const int pn = u.pn, row0 = u.pm * BM + wr * 64 + fr;
        int colb[2];
#pragma unroll
        for (int bj = 0; bj < 2; ++bj) { const int pb = 4 * bj + wc; int sb = pb;
            if (pn == 0) sb = 2 * (pb & 3) + (pb >> 2);
            else if (pn == 1) sb = (pb & 3) < 2 ? 2 * (pb & 3) + (pb >> 2) : (pb < 4 ? pb + 2 : pb);
            colb[bj] = pn * BM + 32 * sb + 8 * fq; }
        const bool donorm = (pn == 0) || (pn == 1 && wc < 2);
        const int rk0 = (pn == 0 || (pn == 1 && wc < 2) || pn == 5 || pn == 6) ? 1 : ((pn == 2 || pn == 3) ? 2 : 0);
        const int rk1 = (pn == 0 || (pn == 1 && wc < 2) || pn == 5) ? 1 : ((pn == 2 || pn == 3) ? 2 : 0);
        const int pa0 = (pn <= 1) ? 4 * fq : 16 * (wc & 1) + 4 * fq, pa1 = (pn <= 1) ? 16 + 4 * fq : 16 * (wc & 1) + 4 * fq;
        const int pb_ = 4 * fq;
        f32x4 fr0 = {0.f, 0.f, 0.f, 0.f}, fr1 = fr0; bool col0 = false, col1 = false;
        if (rk0) { const int p0 = rk0 == 1 ? pa0 : pb_, na = rk0 == 1 ? 16 : 8; col0 = p0 >= na;
#pragma unroll
            for (int i = 0; i < 4; ++i) fr0[i] = exp2f(-(float)((p0 + i) & (na - 1)) * (13.287712379549449f / (float)na)) * 0.15915494309189535f; }
        if (rk1) { const int p1 = rk1 == 1 ? pa1 : pb_, na = rk1 == 1 ? 16 : 8; col1 = p1 >= na;
#pragma unroll
            for (int i = 0; i < 4; ++i) fr1[i] = exp2f(-(float)((p1 + i) & (na - 1)) * (13.287712379549449f / (float)na)) * 0.15915494309189535f; }
        const float* gain = (pn == 0) ? qg : kg;
        f32x4 g00 = {1.f, 1.f, 1.f, 1.f}, g01 = g00, g10 = g00, g11 = g00;
        if (donorm) { g00 = *(const f32x4*)(gain + 8 * fq); g01 = *(const f32x4*)(gain + 8 * fq + 4); g10 = *(const f32x4*)(gain + 32 + 8 * fq); g11 = *(const f32x4*)(gain + 32 + 8 * fq + 4); }
#pragma unroll
        for (int ai = 0; ai < 2; ++ai)
#pragma unroll
            for (int m = 0; m < 4; ++m) {
                const int row = row0 + ai * HALF + m * 16;
                f32x4 v00 = acc[ai][0][m][0], v01 = acc[ai][0][m][1], v10 = acc[ai][1][m][0], v11 = acc[ai][1][m][1];
                if (donorm) {
                    float ss = (v00[0] * v00[0] + v00[1] * v00[1]) + (v00[2] * v00[2] + v00[3] * v00[3]) + (v01[0] * v01[0] + v01[1] * v01[1]) + (v01[2] * v01[2] + v01[3] * v01[3])
                             + (v10[0] * v10[0] + v10[1] * v10[1]) + (v10[2] * v10[2] + v10[3] * v10[3]) + (v11[0] * v11[0] + v11[1] * v11[1]) + (v11[2] * v11[2] + v11[3] * v11[3]);
                    ss += __shfl_xor(ss, 16); ss += __shfl_xor(ss, 32);
                    const float rstd = 1.0f / sqrtf(ss * (1.f / 64.f) + 1e-6f);
                    v00 = v00 * rstd * g00; v01 = v01 * rstd * g01; v10 = v10 * rstd * g10; v11 = v11 * rstd * g11;
                }
                if (row < n_lat_rows && (rk0 | rk1)) {
                    const int t = row % seq; const float prow = (float)(t >> 6), pcol = (float)(t & 63);
                    if (rk0) { f32x4 c, sv; const float ps = col0 ? pcol : prow;
#pragma unroll
                        for (int i = 0; i < 4; ++i) { const float rv = __builtin_amdgcn_fractf(ps * fr0[i]); c[i] = __builtin_amdgcn_cosf(rv); sv[i] = __builtin_amdgcn_sinf(rv); }
                        const f32x4 a = {v00[0] * c[0] - v00[1] * sv[0], v00[0] * sv[0] + v00[1] * c[0], v00[2] * c[1] - v00[3] * sv[1], v00[2] * sv[1] + v00[3] * c[1]};
                        const f32x4 b = {v01[0] * c[2] - v01[1] * sv[2], v01[0] * sv[2] + v01[1] * c[2], v01[2] * c[3] - v01[3] * sv[3], v01[2] * sv[3] + v01[3] * c[3]};
                        v00 = a; v01 = b; }
                    if (rk1) { f32x4 c, sv; const float ps = col1 ? pcol : prow;
#pragma unroll
                        for (int i = 0; i < 4; ++i) { const float rv = __builtin_amdgcn_fractf(ps * fr1[i]); c[i] = __builtin_amdgcn_cosf(rv); sv[i] = __builtin_amdgcn_sinf(rv); }
                        const f32x4 a = {v10[0] * c[0] - v10[1] * sv[0], v10[0] * sv[0] + v10[1] * c[0], v10[2] * c[1] - v10[3] * sv[1], v10[2] * sv[1] + v10[3] * c[1]};
                        const f32x4 b = {v11[0] * c[2] - v11[1] * sv[2], v11[0] * sv[2] + v11[1] * c[2], v11[2] * c[3] - v11[3] * sv[3], v11[2] * sv[3] + v11[3] * c[3]};
                        v10 = a; v11 = b; }
                }
                bf16_t* rowp = O + (size_t)row * ldc;
                u32x4 w; w.x = cvt_pk_bf16(v00[0], v00[1]); w.y = cvt_pk_bf16(v00[2], v00[3]); w.z = cvt_pk_bf16(v01[0], v01[1]); w.w = cvt_pk_bf16(v01[2], v01[3]);
                *(u32x4*)(rowp + colb[0]) = w;
                u32x4 x; x.x = cvt_pk_bf16(v10[0], v10[1]); x.y = cvt_pk_bf16(v10[2], v10[3]); x.z = cvt_pk_bf16(v11[0], v11[1]); x.w = cvt_pk_bf16(v11[2], v11[3]);
                *(u32x4*)(rowp + colb[1]) = x;
            }
    }
};
__device__ __forceinline__ float silu_fast(float a) { return a * __builtin_amdgcn_rcpf(1.0f + __expf(-a)); }
template <bool OUT8>
struct EpiGateUpT {
    static constexpr bool PERM = true, AFTER_DRAIN = false;
    bf16_t* O; int ldc;
    __device__ __forceinline__ void operator()(const f32x4 (&acc)[2][2][4][2], const Unit& u, int wr, int wc, int fr, int fq) const {
        const int row0 = u.pm * BM + wr * 64 + fr, col0 = u.pn * HALF + wc * 32 + 8 * fq;
#pragma unroll
        for (int ai = 0; ai < 2; ++ai)
#pragma unroll
            for (int m = 0; m < 4; ++m) { bf16_t* rowp = O + (size_t)(row0 + ai * HALF + m * 16) * ldc + col0;
                const f32x4 g0 = acc[ai][0][m][0], g1 = acc[ai][0][m][1], u0 = acc[ai][1][m][0], u1 = acc[ai][1][m][1];
                if constexpr (OUT8) {
                    unsigned char* rp8 = (unsigned char*)O + (size_t)(row0 + ai * HALF + m * 16) * ldc + col0;
                    const unsigned lo = pk4_fp8(silu_fast(g0[0]) * u0[0], silu_fast(g0[1]) * u0[1], silu_fast(g0[2]) * u0[2], silu_fast(g0[3]) * u0[3], AS_ACT);
                    const unsigned hi = pk4_fp8(silu_fast(g1[0]) * u1[0], silu_fast(g1[1]) * u1[1], silu_fast(g1[2]) * u1[2], silu_fast(g1[3]) * u1[3], AS_ACT);
                    typedef unsigned u32x2_ __attribute__((ext_vector_type(2))); u32x2_ w8; w8.x = lo; w8.y = hi; *(u32x2_*)rp8 = w8;
                } else {
                u32x4 w; w.x = cvt_pk_bf16(silu_fast(g0[0]) * u0[0], silu_fast(g0[1]) * u0[1]); w.y = cvt_pk_bf16(silu_fast(g0[2]) * u0[2], silu_fast(g0[3]) * u0[3]);
                w.z = cvt_pk_bf16(silu_fast(g1[0]) * u1[0], silu_fast(g1[1]) * u1[1]); w.w = cvt_pk_bf16(silu_fast(g1[2]) * u1[2], silu_fast(g1[3]) * u1[3]);
                *(u32x4*)rowp = w; } }
    }
};
struct BatchOrder {
    int nrt, nN, U, x, j;
    __device__ void init(int M, int N, int c) { nrt = (M / BM > 64) ? 9 : 8; nN = N / BM; U = nrt * nN; x = c & 7; j = c >> 3; }
    __device__ bool next(int i, Unit& u) const {
        const int q = i * 32 + j; if (q >= U) return false;
        const int pl = q / nN; u.pm = pl < 8 ? 8 * x + pl : 64 + x; u.pn = q % nN; return true;
    }
    __device__ __forceinline__ void a_ready(const Unit&) const {}
    __device__ __forceinline__ void done(const Unit&) const {}
};
struct GroupedOrder {
    int ngroups, tpg, tvalid, nN, nwg, G, c; bool pn_fast = false;
    __device__ void init(int ngroups_, int tpg_, int tvalid_, int nN_, int G_, int c_) { ngroups = ngroups_; tpg = tpg_; tvalid = tvalid_; nN = nN_; nwg = ngroups * tvalid * nN; G = G_; c = c_; }
    __device__ bool next(int i, Unit& u) const {
        const long L = (long)i * G + c; if (L >= nwg) return false;
        int wgid = (int)L; { const int q = nwg / NXCD, r = nwg % NXCD, xcd = wgid % NXCD, off = wgid / NXCD; wgid = (xcd < r ? xcd * (q + 1) : r * (q + 1) + (xcd - r) * q) + off; }
        const int per = tvalid * nN, e = wgid / per, rr = wgid % per;
        if (pn_fast) { u.pm = e * tpg + rr / nN; u.pn = rr % nN; }
        else { u.pm = e * tpg + rr % tvalid; u.pn = rr / tvalid; }
        return true;
    }
    __device__ __forceinline__ void a_ready(const Unit&) const {}
    __device__ __forceinline__ void done(const Unit&) const {}
};
constexpr int GIDX_LDS_OFF = STAGE_BYTES + 1024;
typedef int i32x4 __attribute__((ext_vector_type(4)));
typedef int i32x8 __attribute__((ext_vector_type(8)));
template <class Epi, class Sched, bool ALIGN_EPI = false, bool SP2 = false, bool GATHER = false, bool FP8 = false>
__device__ __forceinline__ void gemm_phase(PG8_LAS unsigned char* lds, const Gemm g, const Sched& S, const Epi& E) {
    static_assert(!GATHER || SP2, "GATHER is written for the SP2 loop");
    int tid_ = threadIdx.x; asm volatile("" : "+v"(tid_));
    const int tid = tid_, wid = __builtin_amdgcn_readfirstlane(tid >> 6), lane = tid & 63, wr = wid >> 2, wc = wid & 3, fr = lane & 15, fq = lane >> 4;
    const int K = g.K, nt = K / BK;
    unsigned voffA[2], voffB[2];
#pragma unroll
    for (int i = 0; i < 2; ++i) { int R, C; stage_rc(tid * 16 + i * 8192, R, C); const int Rb = Epi::PERM ? ((R & ~31) + perm32(R & 31)) : R;
        voffA[i] = (unsigned)(R * K + C) * 2u; voffB[i] = (unsigned)(Rb * K + C) * 2u; }
    unsigned offA[2][2] = {{0u, 0u}, {0u, 0u}}, offN[2][2] = {{0u, 0u}, {0u, 0u}}; int gslot[2] = {0, 0}; unsigned gcol[2] = {0u, 0u};
    if constexpr (GATHER) {
#pragma unroll
        for (int i = 0; i < 2; ++i) { int R, C; stage_rc(tid * 16 + i * 8192, R, C); gslot[i] = R; gcol[i] = (unsigned)C * 2u; }
    }
    const size_t kstep = (size_t)(BK * 2);
    const size_t hstep = (size_t)HALF * K * 2;
    const size_t tstep = 2 * hstep;
    const unsigned ldsw = (unsigned)wid * 1024u;
    const int aoff = lds_byte(wr * 64 + fr, fq * 8), boff = lds_byte(wc * 32 + fr, fq * 8);
#define PG8_SA(b, h) (((b) * 2 + (h)) * HTB)
#define PG8_SB(b, h) ((4 + (b) * 2 + (h)) * HTB)
#define PG8_STAGE(bufoff, gbase, voff) do { _Pragma("unroll") for (int _i = 0; _i < 2; ++_i) \
        __builtin_amdgcn_global_load_lds((const unsigned*)((const char*)(gbase) + (voff)[_i]), (PG8_LAS unsigned*)(lds + (bufoff) + ldsw + _i * 8192), 16, 0, 0); } while (0)
#define PG8_STAGE_A(bufoff, ptr, half, OFFS) do { if constexpr (GATHER) { PG8_STAGE(bufoff, ptr, OFFS[half]); } else { PG8_STAGE(bufoff, (ptr) + (half) * hstep, voffA); } } while (0)
#define PG8_LDA(dst, b, h) do { _Pragma("unroll") for (int m = 0; m < 4; ++m) _Pragma("unroll") for (int k = 0; k < 2; ++k) dst[m][k] = *(const PG8_LAS bf16x8*)(lds + PG8_SA(b, h) + aoff + m * 2048 + k * 1024); } while (0)
#define PG8_LDB(dst, b, h) do { _Pragma("unroll") for (int n = 0; n < 2; ++n) _Pragma("unroll") for (int k = 0; k < 2; ++k) dst[n][k] = *(const PG8_LAS bf16x8*)(lds + PG8_SB(b, h) + boff + n * 2048 + k * 1024); } while (0)
#define PG8_CAT(x0, x1) __builtin_shufflevector(__builtin_bit_cast(i32x4, x0), __builtin_bit_cast(i32x4, x1), 0, 1, 2, 3, 4, 5, 6, 7)
#define PG8_MMA(ai, bj, At, Bt) do { __builtin_amdgcn_s_setprio(1); \
        if constexpr (FP8) { _Pragma("unroll") for (int m = 0; m < 4; ++m) _Pragma("unroll") for (int n = 0; n < 2; ++n) \
            asm volatile("v_mfma_f32_16x16x128_f8f6f4 %0, %1, %2, %0" : "+v"(acc[ai][bj][m][n]) : "v"(PG8_CAT(Bt[n][0], Bt[n][1])), "v"(PG8_CAT(At[m][0], At[m][1]))); } \
        else { _Pragma("unroll") for (int m = 0; m < 4; ++m) _Pragma("unroll") for (int n = 0; n < 2; ++n) _Pragma("unroll") for (int k = 0; k < 2; ++k) \
            acc[ai][bj][m][n] = __builtin_amdgcn_mfma_f32_16x16x32_bf16(Bt[n][k], At[m][k], acc[ai][bj][m][n], 0, 0, 0); } \
        __builtin_amdgcn_s_setprio(0); } while (0)
#define PG8_WAIT_V(n) asm volatile("s_waitcnt vmcnt(" #n ")" ::: "memory")
#define PG8_WAIT_L(n) asm volatile("s_waitcnt lgkmcnt(" #n ")" ::: "memory")
#define PG8_BAR __builtin_amdgcn_s_barrier()
#define PG8_SCHED __builtin_amdgcn_sched_barrier(0)
    Unit cur, nxt; int ui = 0;
    if (!S.next(0, cur)) return;
    f32x4 acc[2][2][4][2];
#pragma unroll
    for (int a = 0; a < 2; ++a)
#pragma unroll
        for (int b = 0; b < 2; ++b)
#pragma unroll
            for (int m = 0; m < 4; ++m)
#pragma unroll
                for (int n = 0; n < 2; ++n) acc[a][b][m][n] = (f32x4){0.f, 0.f, 0.f, 0.f};
    bf16x8 At[4][2], B0[2][2], B1[2][2];
    const char* cA = GATHER ? (const char*)g.A : (const char*)g.A + (size_t)cur.pm * tstep; const char* cB = gemm_bbase(g, cur, tstep);
    if constexpr (GATHER) {
#pragma unroll
        for (int h = 0; h < 2; ++h)
#pragma unroll
            for (int i = 0; i < 2; ++i) offA[h][i] = (unsigned)g.gather[cur.pm * BM + h * HALF + gslot[i]] * (unsigned)(K * 2) + gcol[i];
    }
    S.a_ready(cur);
    if constexpr (SP2) {
        PG8_STAGE(PG8_SB(0, 0), cB, voffB); PG8_STAGE(PG8_SB(0, 1), cB + hstep, voffB); PG8_STAGE_A(PG8_SA(0, 0), cA, 0, offA); PG8_STAGE_A(PG8_SA(0, 1), cA, 1, offA);
        if (wr == 1) PG8_BAR;
        PG8_WAIT_V(2); PG8_BAR;
        PG8_STAGE(PG8_SB(1, 0), cB + kstep, voffB); PG8_STAGE_A(PG8_SA(1, 0), cA + kstep, 0, offA); PG8_STAGE(PG8_SB(1, 1), cB + hstep + kstep, voffB);
        PG8_WAIT_V(6); PG8_BAR;
    } else {
        PG8_STAGE(PG8_SB(0, 0), cB, voffB); PG8_STAGE(PG8_SA(0, 0), cA, voffA); PG8_STAGE(PG8_SB(0, 1), cB + hstep, voffB); PG8_STAGE(PG8_SA(0, 1), cA + hstep, voffA);
        if (wr == 1) PG8_BAR;
        PG8_WAIT_V(4); PG8_BAR;
        PG8_STAGE(PG8_SB(1, 0), cB + kstep, voffB); PG8_STAGE(PG8_SA(1, 0), cA + kstep, voffA); PG8_STAGE(PG8_SB(1, 1), cB + hstep + kstep, voffB);
        PG8_WAIT_V(6); PG8_BAR;
    }
    for (;;) {
        const bool has_next = S.next(ui + 1, nxt);
        const char* nA = GATHER ? cA : (has_next ? (const char*)g.A + (size_t)nxt.pm * tstep : cA); const char* nB = has_next ? gemm_bbase(g, nxt, tstep) : cB;
        if constexpr (GATHER) { if (has_next && wid == 0) {
            const int l4 = 4 * (int)__builtin_amdgcn_mbcnt_hi(~0u, __builtin_amdgcn_mbcnt_lo(~0u, 0u));
            __builtin_amdgcn_global_load_lds((const unsigned*)(g.gather + nxt.pm * BM + l4), (PG8_LAS unsigned*)(lds + GIDX_LDS_OFF + (ui & 1) * 1024), 16, 0, 0); } }
        for (int t = 0; t < nt; t += 2) {
            const bool last = (t == nt - 2);
            const char* a1 = cA + (size_t)(t + 1) * kstep;
            const char* a2 = last ? nA : cA + (size_t)(t + 2) * kstep; const char* b2 = last ? nB : cB + (size_t)(t + 2) * kstep;
            const char* a3 = a2 + kstep; const char* b3 = b2 + kstep;
            if (last && has_next) S.a_ready(nxt);
            unsigned offS[2][2] = {{0u, 0u}, {0u, 0u}};
            if constexpr (GATHER) {
                if (last) {
#pragma unroll
                    for (int h = 0; h < 2; ++h)
#pragma unroll
                        for (int i = 0; i < 2; ++i) offN[h][i] = has_next ? (*(const PG8_LAS unsigned*)(lds + GIDX_LDS_OFF + (ui & 1) * 1024 + (h * HALF + gslot[i]) * 4)) * (unsigned)(K * 2) + gcol[i] : offA[h][i];
                }
#pragma unroll
                for (int h = 0; h < 2; ++h)
#pragma unroll
                    for (int i = 0; i < 2; ++i) offS[h][i] = last ? offN[h][i] : offA[h][i];
            }
            if constexpr (SP2) {
            PG8_LDB(B0, 0, 0); PG8_LDB(B1, 0, 1); PG8_SCHED; PG8_LDA(At, 0, 0); PG8_STAGE_A(PG8_SA(1, 1), a1, 1, offA);
            PG8_WAIT_V(8); PG8_WAIT_L(0); PG8_BAR; PG8_MMA(0, 0, At, B0); PG8_MMA(0, 1, At, B1); PG8_BAR; PG8_SCHED;
            PG8_LDA(At, 0, 1); PG8_STAGE(PG8_SB(0, 0), b2, voffB); PG8_STAGE(PG8_SB(0, 1), b2 + hstep, voffB); PG8_STAGE_A(PG8_SA(0, 0), a2, 0, offS);
            PG8_WAIT_V(8); PG8_WAIT_L(0); PG8_BAR; PG8_MMA(1, 0, At, B0); PG8_MMA(1, 1, At, B1); PG8_BAR; PG8_SCHED;
            PG8_LDB(B0, 1, 0); PG8_LDB(B1, 1, 1); PG8_SCHED; PG8_LDA(At, 1, 0); PG8_STAGE_A(PG8_SA(0, 1), a2, 1, offS);
            PG8_WAIT_V(8); PG8_WAIT_L(0); PG8_BAR; PG8_MMA(0, 0, At, B0); PG8_MMA(0, 1, At, B1); PG8_BAR; PG8_SCHED;
            PG8_LDA(At, 1, 1); PG8_STAGE(PG8_SB(1, 0), b3, voffB); PG8_STAGE(PG8_SB(1, 1), b3 + hstep, voffB); PG8_STAGE_A(PG8_SA(1, 0), a3, 0, offS);
            PG8_WAIT_V(8); PG8_WAIT_L(0); PG8_BAR; PG8_MMA(1, 0, At, B0); PG8_MMA(1, 1, At, B1); PG8_BAR; PG8_SCHED;
            } else {
            PG8_LDB(B0, 0, 0); PG8_SCHED; PG8_LDA(At, 0, 0); PG8_STAGE(PG8_SA(1, 1), a1 + hstep, voffA);
            PG8_WAIT_L(8); PG8_BAR; PG8_WAIT_L(0); PG8_MMA(0, 0, At, B0); PG8_BAR; PG8_SCHED;
            PG8_LDB(B1, 0, 1); PG8_STAGE(PG8_SB(0, 0), b2, voffB);
            PG8_BAR; PG8_WAIT_L(0); PG8_MMA(0, 1, At, B1); PG8_BAR;
            PG8_LDA(At, 0, 1); PG8_STAGE(PG8_SA(0, 0), a2, voffA);
            PG8_BAR; PG8_WAIT_L(0); PG8_MMA(1, 0, At, B0); PG8_BAR; PG8_SCHED;
            PG8_STAGE(PG8_SB(0, 1), b2 + hstep, voffB);
            PG8_WAIT_V(6); PG8_BAR; PG8_MMA(1, 1, At, B1); PG8_BAR;
            PG8_LDB(B0, 1, 0); PG8_SCHED; PG8_LDA(At, 1, 0); PG8_STAGE(PG8_SA(0, 1), a2 + hstep, voffA);
            PG8_WAIT_L(8); PG8_BAR; PG8_WAIT_L(0); PG8_MMA(0, 0, At, B0); PG8_BAR; PG8_SCHED;
            PG8_LDB(B1, 1, 1); PG8_STAGE(PG8_SB(1, 0), b3, voffB);
            PG8_BAR; PG8_WAIT_L(0); PG8_MMA(0, 1, At, B1); PG8_BAR;
            PG8_LDA(At, 1, 1); PG8_STAGE(PG8_SA(1, 0), a3, voffA);
            PG8_BAR; PG8_WAIT_L(0); PG8_MMA(1, 0, At, B0); PG8_BAR; PG8_SCHED;
            PG8_STAGE(PG8_SB(1, 1), b3 + hstep, voffB);
            PG8_WAIT_V(6); PG8_BAR; PG8_MMA(1, 1, At, B1); PG8_BAR;
            }
        }
        if constexpr (ALIGN_EPI) { if (wr == 0) PG8_BAR; }
        if constexpr (FP8) { const float dq_ = g.dq; asm volatile("s_nop 15\n\ts_nop 15" ::: "memory");
#pragma unroll
            for (int a = 0; a < 2; ++a)
#pragma unroll
                for (int b = 0; b < 2; ++b)
#pragma unroll
                    for (int m = 0; m < 4; ++m)
#pragma unroll
                        for (int n = 0; n < 2; ++n) acc[a][b][m][n] *= dq_; }
        if constexpr (!Epi::AFTER_DRAIN) { E(acc, cur, wr, wc, fr, fq); S.done(cur); }
        if (!has_next) break;
#pragma unroll
        for (int a = 0; a < 2; ++a)
#pragma unroll
            for (int b = 0; b < 2; ++b)
#pragma unroll
                for (int m = 0; m < 4; ++m)
#pragma unroll
                    for (int n = 0; n < 2; ++n) acc[a][b][m][n] = (f32x4){0.f, 0.f, 0.f, 0.f};
        cur = nxt; cA = nA; cB = nB; ++ui;
        if constexpr (GATHER) {
#pragma unroll
            for (int h = 0; h < 2; ++h)
#pragma unroll
                for (int i = 0; i < 2; ++i) offA[h][i] = offN[h][i];
        }
        if constexpr (ALIGN_EPI) { if (wr == 1) PG8_BAR; }
    }
    PG8_WAIT_V(0);
    if constexpr (!ALIGN_EPI) { if (wr == 0) PG8_BAR; }
    PG8_BAR;
    if constexpr (Epi::AFTER_DRAIN) { E.fused(acc, cur, wr, wc, fr, fq, lds, wid, lane); S.done(cur); }
#undef PG8_SA
#undef PG8_SB
#undef PG8_STAGE
#undef PG8_STAGE_A
#undef PG8_LDA
#undef PG8_LDB
#undef PG8_MMA
#undef PG8_CAT
#undef PG8_WAIT_V
#undef PG8_WAIT_L
#undef PG8_BAR
#undef PG8_SCHED
}
}

struct Args { const float* in[25]; float* out; unsigned char* ws; int ph_lo, ph_hi; };
#define CAS __attribute__((address_space(4)))
struct Frame {
    LAS unsigned char* lds;
    int tid, lane, wave, G, bid;
    const CAS Args* ka;
    __device__ __forceinline__ const float* x() const { return ka->in[0]; }
    __device__ __forceinline__ const float* c() const { return ka->in[1]; }
    __device__ __forceinline__ const float* ctx() const { return ka->in[2]; }
    __device__ __forceinline__ const float* c_ctx() const { return ka->in[3]; }
    __device__ __forceinline__ const float* w_ada() const { return ka->in[4]; }
    __device__ __forceinline__ const float* b_ada() const { return ka->in[5]; }
    __device__ __forceinline__ const float* g_pre_mix() const { return ka->in[6]; }
    __device__ __forceinline__ const float* g_post_mix() const { return ka->in[7]; }
    __device__ __forceinline__ const float* g_pre_ffn() const { return ka->in[8]; }
    __device__ __forceinline__ const float* g_post_ffn() const { return ka->in[9]; }
    __device__ __forceinline__ const float* w_in() const { return ka->in[10]; }
    __device__ __forceinline__ const float* w_out() const { return ka->in[11]; }
    __device__ __forceinline__ const float* q_gain_a() const { return ka->in[12]; }
    __device__ __forceinline__ const float* k_gain_a() const { return ka->in[13]; }
    __device__ __forceinline__ const float* lam_q1() const { return ka->in[14]; }
    __device__ __forceinline__ const float* lam_k1() const { return ka->in[15]; }
    __device__ __forceinline__ const float* lam_q2() const { return ka->in[16]; }
    __device__ __forceinline__ const float* lam_k2() const { return ka->in[17]; }
    __device__ __forceinline__ const float* subln() const { return ka->in[18]; }
    __device__ __forceinline__ const float* sink() const { return ka->in[19]; }
    __device__ __forceinline__ const float* rpb() const { return ka->in[20]; }
    __device__ __forceinline__ const float* w_router() const { return ka->in[21]; }
    __device__ __forceinline__ const float* w_gate() const { return ka->in[22]; }
    __device__ __forceinline__ const float* w_up() const { return ka->in[23]; }
    __device__ __forceinline__ const float* w_down() const { return ka->in[24]; }
    __device__ __forceinline__ float* out() const { return ka->out; }
    __device__ __forceinline__ unsigned char* ws() const { return ka->ws; }
    __device__ __forceinline__ float* mod() const { return (float*)(ws() + WS_MOD); }
    __device__ __forceinline__ float* cosA() const { return (float*)(ws() + WS_ROPE); }
    __device__ __forceinline__ float* sinA() const { return cosA() + SEQ * 32; }
    __device__ __forceinline__ float* cosB() const { return cosA() + SEQ * 64; }
    __device__ __forceinline__ float* sinB() const { return cosA() + SEQ * 80; }
    __device__ __forceinline__ float* affT() const { return (float*)(ws() + WS_AFF); }
    __device__ __forceinline__ float* affcT() const { return affT() + NB * NE * SEQ; }
    __device__ __forceinline__ int* slot() const { return (int*)(ws() + WS_SLOT); }
    __device__ __forceinline__ int* slotc() const { return slot() + NB * SEQ * NE; }
    __device__ __forceinline__ float* gate() const { return (float*)(ws() + WS_GATE); }
    __device__ __forceinline__ int* rowidx() const { return (int*)(ws() + WS_GATE + 512 * 1024); }
    __device__ __forceinline__ float* xcw() const { return (float*)(ws() + WS_XC); }
    __device__ __forceinline__ bf16* xb() const { return (bf16*)(ws() + WS_XB); }
    __device__ __forceinline__ bf16* win_t() const { return (bf16*)(ws() + WS_WIN); }
    __device__ __forceinline__ bf16* wout_t() const { return (bf16*)(ws() + WS_WOUT); }
    __device__ __forceinline__ bf16* wgu_t() const { return (bf16*)(ws() + WS_WGU); }
    __device__ __forceinline__ bf16* wdn_t() const { return (bf16*)(ws() + WS_WDN); }
    __device__ __forceinline__ bf16* h() const { return (bf16*)(ws() + WS_H); }
    __device__ __forceinline__ bf16* o() const { return (bf16*)(ws() + WS_O); }
    __device__ __forceinline__ bf16* p() const { return (bf16*)(ws() + WS_P); }
    __device__ __forceinline__ float* op() const { return (float*)(ws() + WS_P); }
    __device__ __forceinline__ bf16* opb() const { return (bf16*)(ws() + WS_ACT); }
    __device__ __forceinline__ bf16* xe() const { return (bf16*)(ws() + WS_P); }
    __device__ __forceinline__ bf16* Y() const { return (bf16*)(ws() + WS_P); }
    __device__ __forceinline__ bf16* act() const { return (bf16*)(ws() + WS_ACT); }
};


#define FOR_ROWS(F, row, nrows_) \
    for (int it_ = 0, row = 0; ; ++it_) if (((F).G == 256) ? (it_ >= 9 || ((row = it_ < 8 ? ((F).bid & 7) * SEQ + ((F).bid >> 3) * 8 + (F).wave + 256 * it_ : ML + ((F).bid & 7) * LC + ((F).bid >> 3) * 8 + (F).wave), row >= (nrows_))) \
                                                            : ((row = (F).bid * NWAVES + (F).wave + it_ * (F).G * NWAVES), row >= (nrows_))) break; else

__device__ __forceinline__ void transpose_item(const float* W, int K, int N, bf16* WT, int k0, int n0, int dst_row0, LAS float* scr, int lane, bool out8) {
    f32x4 tv[8];
    const float* wp = W + (size_t)(k0 + (lane >> 3)) * N + n0 + 4 * (lane & 7);
    size_t wstride = (size_t)8 * N; asm volatile("" : "+v"(wstride));
#pragma unroll
    for (int i = 0; i < 8; ++i) { tv[i] = *(const f32x4*)wp; wp += wstride; }
#pragma unroll
    for (int i = 0; i < 8; ++i) { LAS float* d_ = scr + ((lane >> 3) + 8 * i) * 33 + 4 * (lane & 7); d_[0] = tv[i].x; d_[1] = tv[i].y; d_[2] = tv[i].z; d_[3] = tv[i].w; }
    LDS_WAIT(); asm volatile("" ::: "memory");
    const int c = lane & 7;
#pragma unroll
    for (int j = 0; j < 4; ++j) { const int n = (lane >> 3) + 8 * j; const LAS float* s = scr + (8 * c) * 33 + n;
        if (out8) { v2u o8; o8.x = pk4_fp8(s[0 * 33], s[1 * 33], s[2 * 33], s[3 * 33], WS8); o8.y = pk4_fp8(s[4 * 33], s[5 * 33], s[6 * 33], s[7 * 33], WS8);
            *(v2u*)((unsigned char*)WT + (size_t)(dst_row0 + n) * K + k0 + 8 * c) = o8; }
        else {
        v4u o; o.x = pk2(s[0 * 33], s[1 * 33]); o.y = pk2(s[2 * 33], s[3 * 33]); o.z = pk2(s[4 * 33], s[5 * 33]); o.w = pk2(s[6 * 33], s[7 * 33]);
        *(v4u*)(WT + (size_t)(dst_row0 + n) * K + k0 + 8 * c) = o; } }
    LDS_WAIT(); asm volatile("" ::: "memory");
}

constexpr int CVT_I_IN = 16 * 80, CVT_I_OUT = 16 * 32, CVT_I_E = 16 * 32;
constexpr int CVT_N_IN = DEPTH * CVT_I_IN, CVT_N_OUT = DEPTH * CVT_I_OUT, CVT_N_EX = DEPTH * NE * 3 * CVT_I_E;
constexpr int CVT_N0 = CVT_N_IN + CVT_N_OUT + CVT_N_EX / 2, CVT_NT = CVT_N_IN + CVT_N_OUT + CVT_N_EX;
constexpr int CVT_W_QKV = 48 * NWAVES, CVT_W_OUT = 224 * NWAVES, CVT_W_GU = 128 * NWAVES, CVT_W_DN = 192 * NWAVES;
constexpr int CVT_A = CVT_N0 + 6 * CVT_W_QKV, CVT_B = CVT_A + 5 * CVT_W_OUT, CVT_C = CVT_B + 5 * CVT_W_GU;
static_assert(CVT_C < CVT_NT && (CVT_NT - CVT_C + CVT_W_DN - 1) / CVT_W_DN <= 6, "deferred conversion split");
#ifndef CVT_ATT
#define CVT_ATT 1
#endif
static_assert(!CVT_ATT || (FP8_GEMMS & 12) == 12, "CVT_ATT writes e4m3 expert weights");
constexpr int CVT_ATT_PER_WAVE = 12;
static_assert(CVT_N_EX / 2 == 256 * NWAVES * CVT_ATT_PER_WAVE, "CVT_ATT item split");
__device__ __forceinline__ void cvt_att_decode(Frame& F, int idx, const float*& W, unsigned char*& WT, int& k0, int& n0, int& drow) {
    const int r = idx - (CVT_N_IN + CVT_N_OUT), le = r / (3 * CVT_I_E), rem = r % (3 * CVT_I_E), which = rem / CVT_I_E, q = rem % CVT_I_E; k0 = (q / 32) * 64; n0 = (q % 32) * 32;
    if (which == 2) { W = F.w_down() + (size_t)le * D * D; WT = (unsigned char*)(F.wdn_t() + (size_t)le * D * D); drow = n0; }
    else { W = (which == 0 ? F.w_gate() : F.w_up()) + (size_t)le * D * D; WT = (unsigned char*)(F.wgu_t() + (size_t)le * 2048 * D); drow = 256 * (n0 / 128) + (n0 % 128) + (which == 1 ? 128 : 0); }
}
__device__ __forceinline__ void cvt_att_step(Frame& F, int cv0, int t, LAS unsigned char* cvb, int lane) {
    const int n = lane & 31, kh = lane >> 5;
    float tv[32];
    if (t >= 1) {
#pragma unroll
        for (int i = 0; i < 32; ++i) tv[i] = *(const LAS float*)(cvb + (32 * kh + i) * 128 + 4 * n);
        LDS_WAIT(); asm volatile("" ::: "memory");
    }
    if (t < CVT_ATT_PER_WAVE) {
        const float* W; unsigned char* WT; int k0, n0, drow; cvt_att_decode(F, cv0 + t, W, WT, k0, n0, drow);
        const float* src = W + (size_t)(k0 + (lane >> 3)) * D + n0 + (lane & 7) * 4;
#pragma unroll
        for (int j = 0; j < 8; ++j) __builtin_amdgcn_global_load_lds((const unsigned*)(src + (size_t)(8 * j) * D), (LAS unsigned*)(cvb + j * 1024), 16, 0, 0);
    }
    if (t >= 1) {
        const float* W; unsigned char* WT; int k0, n0, drow; cvt_att_decode(F, cv0 + t - 1, W, WT, k0, n0, drow);
        unsigned char* dst = WT + (size_t)(drow + n) * D + k0 + 32 * kh;
#pragma unroll
        for (int h = 0; h < 2; ++h) { v4u o; o.x = pk4_fp8(tv[16 * h + 0], tv[16 * h + 1], tv[16 * h + 2], tv[16 * h + 3], WS8); o.y = pk4_fp8(tv[16 * h + 4], tv[16 * h + 5], tv[16 * h + 6], tv[16 * h + 7], WS8);
            o.z = pk4_fp8(tv[16 * h + 8], tv[16 * h + 9], tv[16 * h + 10], tv[16 * h + 11], WS8); o.w = pk4_fp8(tv[16 * h + 12], tv[16 * h + 13], tv[16 * h + 14], tv[16 * h + 15], WS8);
            *(v4u*)(dst + 16 * h) = o; }
    }
}
__device__ __forceinline__ void convert_items(Frame& F, int begin, int end, int start, int stride) {
    LAS float* scr = (LAS float*)(F.lds + F.wave * 16384);
    for (int it = begin + start; it < end; it += stride) {
        int r = it; const float* W; bf16* WT; int N, k0, n0, drow; bool o8 = false;
        if (r < CVT_N_IN) { o8 = (FP8_GEMMS & 1) != 0; const int l = r / CVT_I_IN, q = r % CVT_I_IN; W = F.w_in() + (size_t)l * D * PROJ; WT = F.win_t() + (size_t)l * PROJ * D; N = PROJ; k0 = (q / 80) * 64; n0 = (q % 80) * 32; drow = n0;
            { const int sb = (n0 >> 5) & 7;
              if (n0 < 256) drow = 32 * (4 * (sb & 1) + (sb >> 1));
              else if (n0 < 512) drow = 256 + 32 * (sb < 4 ? 4 * (sb & 1) + (sb >> 1) : (sb < 6 ? sb - 2 : sb)); } }
        else if ((r -= CVT_N_IN) < CVT_N_OUT) { o8 = (FP8_GEMMS & 2) != 0; const int l = r / CVT_I_OUT, q = r % CVT_I_OUT; W = F.w_out() + (size_t)l * D * D; WT = F.wout_t() + (size_t)l * D * D; N = D; k0 = (q / 32) * 64; n0 = (q % 32) * 32; drow = n0; }
        else { r -= CVT_N_OUT; const int le = r / (3 * CVT_I_E), rem = r % (3 * CVT_I_E), which = rem / CVT_I_E, q = rem % CVT_I_E; N = D; k0 = (q / 32) * 64; n0 = (q % 32) * 32;
            o8 = (which == 2) ? (FP8_GEMMS & 8) != 0 : (FP8_GEMMS & 4) != 0;
            if (which == 2) { W = F.w_down() + (size_t)le * D * D; WT = F.wdn_t() + (size_t)le * D * D; drow = n0; }
            else { W = (which == 0 ? F.w_gate() : F.w_up()) + (size_t)le * D * D; WT = F.wgu_t() + (size_t)le * 2048 * D; drow = 256 * (n0 / 128) + (n0 % 128) + (which == 1 ? 128 : 0); } }
        transpose_item(W, D, N, WT, k0, n0, drow, scr, F.lane, o8);
    }
}

__device__ __forceinline__ void ph_prologue(Frame& F) {
    {
        LAS float* sl = (LAS float*)F.lds;
        LAS float* red = sl + 9 * 1024;
        {
            float tv[18];
#pragma unroll
            for (int q = 0; q < 18; ++q) { const int i = F.tid + NTHR * q; tv[q] = (q < 16) ? F.c()[i] : F.c_ctx()[i - 8 * 1024]; }
#pragma unroll
            for (int q = 0; q < 18; ++q) { const float v = tv[q]; sl[F.tid + NTHR * q] = v / (1.f + expf(-v)); }
        }
        __syncthreads();
        for (int it = F.bid; it < 2 * 96; it += F.G) {
            const int l = it / 96, n0 = (it % 96) * 64;
            const float* W = F.w_ada() + (size_t)l * D * 6144 + n0 + F.lane;
            float acc[9];
#pragma unroll
            for (int r = 0; r < 9; ++r) acc[r] = 0.f;
            const int kb = F.wave * 128;
#pragma unroll 8
            for (int k = 0; k < 128; ++k) { const float w = W[(size_t)(kb + k) * 6144];
#pragma unroll
                for (int r = 0; r < 9; ++r) acc[r] = fmaf(sl[r * 1024 + kb + k], w, acc[r]); }
#pragma unroll
            for (int r = 0; r < 9; ++r) red[(F.wave * 9 + r) * 64 + F.lane] = acc[r];
            __syncthreads();
            for (int i = F.tid; i < 9 * 64; i += NTHR) { const int r = i / 64, cl = i % 64; float s = 0.f;
#pragma unroll
                for (int w = 0; w < 8; ++w) s += red[(w * 9 + r) * 64 + cl];
                F.mod()[((size_t)l * 9 + r) * 6144 + n0 + cl] = s + F.b_ada()[l * 6144 + n0 + cl]; }
            __syncthreads();
        }
    }
    __syncthreads();
    {
        const size_t gt = (size_t)F.bid * NTHR + F.tid, NT = (size_t)F.G * NTHR;
        for (size_t i = gt; NAIVE_GEMM && i < (size_t)SEQ * 48; i += NT) {
            const int t = (int)(i / 48), j = (int)(i % 48);
            const float row = (float)(t / GRIDW), col = (float)(t % GRIDW);
            const bool isA = j < 32; const int jb = isA ? j : j - 32, na = isA ? 16 : 8, ia = jb & (na - 1);
            const float inv = exp2f(-(float)ia * (13.287712379549449f / (float)na));
            const float ang = (jb < na ? row : col) * inv;
            const float kq = rintf(ang * 0.15915494309189535f);
            float rr = fmaf(-kq, 6.28125f, ang); rr = fmaf(-kq, 1.9353071795864769e-3f, rr);
            const float cv = cosf(rr), sv = sinf(rr);
            if (isA) { F.cosA()[t * 32 + j] = cv; F.sinA()[t * 32 + j] = sv; } else { F.cosB()[t * 16 + jb] = cv; F.sinB()[t * 16 + jb] = sv; }
        }
    }
}

__device__ __forceinline__ void norm_mod_store(const f32x4 (&v)[4], const float* g, const float* sh, const float* sc, bf16* dst, int lane) {
    float ss = 0.f;
#pragma unroll
    for (int j = 0; j < 4; ++j) ss += (v[j].x * v[j].x + v[j].y * v[j].y) + (v[j].z * v[j].z + v[j].w * v[j].w);
    const float rstd = 1.0f / sqrtf(wave_sum(ss) * (1.f / D) + EPS);
#pragma unroll
    for (int j = 0; j < 4; ++j) { const int c0 = 4 * lane + 256 * j;
        const f32x4 gg = *(const f32x4*)(g + c0), s1 = *(const f32x4*)(sh + c0), s2 = *(const f32x4*)(sc + c0);
        const f32x4 o = (v[j] * rstd * gg) * (1.0f + s2) + s1;
        if constexpr ((FP8_GEMMS & 1) != 0) *(unsigned*)((unsigned char*)dst + c0) = pk4_fp8(o.x, o.y, o.z, o.w, AS_H);
        else { v2u w; w.x = pk2(o.x, o.y); w.y = pk2(o.z, o.w);
        *(v2u*)(dst + c0) = w; } }
}
#define N1_ROW_OF(F, it) ((it) < 8 ? ((F).bid & 7) * SEQ + ((F).bid >> 3) * 8 + (F).wave + 256 * (it) : ML + ((F).bid & 7) * LC + ((F).bid >> 3) * 8 + (F).wave)
__device__ __forceinline__ void ph_norm1(Frame& F, int l) {
    f32x4 pg[4], psh[4], psc[4];
#define N1_PARAMS(mrow_) do { const float* md_ = F.mod() + ((size_t)l * 9 + (mrow_)) * 6144; \
        _Pragma("unroll") for (int j = 0; j < 4; ++j) { const int c0 = 4 * F.lane + 256 * j; pg[j] = *(const f32x4*)(F.g_pre_mix() + l * D + c0); psh[j] = *(const f32x4*)(md_ + c0); psc[j] = *(const f32x4*)(md_ + 1024 + c0); } } while (0)
#define N1_ROWPTR(row_) ((row_) < ML ? F.x() + (size_t)(row_) * D : F.ctx() + (size_t)((row_) - ML) * D)
    N1_PARAMS(F.bid & 7);
    int row = N1_ROW_OF(F, 0);
    f32x4 vn[4];
    { const float* xr = N1_ROWPTR(row);
#pragma unroll
      for (int j = 0; j < 4; ++j) vn[j] = *(const f32x4*)(xr + 4 * F.lane + 256 * j); }
#pragma unroll 1
    for (int it = 0; it < 9 && row < MT; ++it) {
        f32x4 v[4];
#pragma unroll
        for (int j = 0; j < 4; ++j) v[j] = vn[j];
        const int nrow = (it + 1 < 9) ? N1_ROW_OF(F, it + 1) : MT;
        if (nrow < MT) { const float* xr = N1_ROWPTR(nrow);
#pragma unroll
            for (int j = 0; j < 4; ++j) vn[j] = *(const f32x4*)(xr + 4 * F.lane + 256 * j); }
        if (row >= ML) N1_PARAMS(8);
        float ss = 0.f;
#pragma unroll
        for (int j = 0; j < 4; ++j) ss += (v[j].x * v[j].x + v[j].y * v[j].y) + (v[j].z * v[j].z + v[j].w * v[j].w);
        const float rstd = 1.0f / sqrtf(wave_sum(ss) * (1.f / D) + EPS);
#pragma unroll
        for (int j = 0; j < 4; ++j) { const int c0 = 4 * F.lane + 256 * j;
            const f32x4 o = (v[j] * rstd * pg[j]) * (1.0f + psc[j]) + psh[j];
            if constexpr ((FP8_GEMMS & 1) != 0) *(unsigned*)((unsigned char*)F.h() + (size_t)row * D + c0) = pk4_fp8(o.x, o.y, o.z, o.w, AS_H);
            else { v2u w; w.x = pk2(o.x, o.y); w.y = pk2(o.z, o.w); *(v2u*)(F.h() + (size_t)row * D + c0) = w; } }
        row = nrow;
    }
#undef N1_PARAMS
#undef N1_ROWPTR
#undef N1_ROW_OF
}

struct EpiNBf16 { bf16* C; int ldc;
    __device__ __forceinline__ void operator()(int row, int col, f32x4 lo, f32x4 hi) const {
        v2u a; a.x = pk2(lo.x, lo.y); a.y = pk2(lo.z, lo.w); *(v2u*)(C + (size_t)row * ldc + col) = a;
        v2u b; b.x = pk2(hi.x, hi.y); b.y = pk2(hi.z, hi.w); *(v2u*)(C + (size_t)row * ldc + col + 128) = b; } };
struct EpiNF32 { float* C; int ldc;
    __device__ __forceinline__ void operator()(int row, int col, f32x4 lo, f32x4 hi) const {
        *(f32x4*)(C + (size_t)row * ldc + col) = lo; *(f32x4*)(C + (size_t)row * ldc + col + 128) = hi; } };
__device__ __forceinline__ float silu_f(float a) { return a / (1.f + expf(-a)); }
struct EpiNGateUp { bf16* C;
    __device__ __forceinline__ void operator()(int row, int col, f32x4 lo, f32x4 hi) const {
        const int f = (col >> 8) * 128 + (col & 255);
        v2u a; a.x = pk2(silu_f(lo.x) * hi.x, silu_f(lo.y) * hi.y); a.y = pk2(silu_f(lo.z) * hi.z, silu_f(lo.w) * hi.w);
        *(v2u*)(C + (size_t)row * D + f) = a; } };

template <class Epi>
__device__ __forceinline__ void gemm_naive(Frame& F, const bf16* A, const bf16* Bt, int M, int N, int rows_per_group, size_t b_group_stride, int skip_from, const Epi& epi) {
    constexpr int K = D;
    LAS float* As = (LAS float*)F.lds;
    LAS float* Bs = As + 32 * 132;
    const int nNt = N / 256, nT = (M / 128) * nNt;
    const int ty = F.tid >> 5, tx = F.tid & 31;
    for (int tile = F.bid; tile < nT; tile += F.G) {
        const int mt = tile / nNt, nt = tile % nNt;
        if (rows_per_group && ((mt * 128) % rows_per_group) >= skip_from) continue;
        const bf16* Ab = A + (size_t)mt * 128 * K;
        const bf16* Bb = Bt + (rows_per_group ? (size_t)((mt * 128) / rows_per_group) * b_group_stride : 0) + (size_t)nt * 256 * K;
        float acc[8][8];
#pragma unroll
        for (int i = 0; i < 8; ++i)
#pragma unroll
            for (int j = 0; j < 8; ++j) acc[i][j] = 0.f;
        for (int k0 = 0; k0 < K; k0 += 32) {
            { const int r = F.tid >> 2, kc = (F.tid & 3) * 8; float f[8]; ld8(Ab + (size_t)r * K + k0 + kc, f);
#pragma unroll
              for (int i = 0; i < 8; ++i) As[(kc + i) * 132 + r] = f[i]; }
#pragma unroll
            for (int hh = 0; hh < 2; ++hh) { const int r = (F.tid >> 2) + hh * 128, kc = (F.tid & 3) * 8; float f[8]; ld8(Bb + (size_t)r * K + k0 + kc, f);
#pragma unroll
              for (int i = 0; i < 8; ++i) Bs[(kc + i) * 260 + r] = f[i]; }
            __syncthreads();
#pragma unroll 4
            for (int kk = 0; kk < 32; ++kk) {
                const f32x4 a0 = *(const LAS f32x4*)(As + kk * 132 + ty * 8), a1 = *(const LAS f32x4*)(As + kk * 132 + ty * 8 + 4);
                const f32x4 b0 = *(const LAS f32x4*)(Bs + kk * 260 + tx * 4), b1 = *(const LAS f32x4*)(Bs + kk * 260 + 128 + tx * 4);
                const float a[8] = {a0.x, a0.y, a0.z, a0.w, a1.x, a1.y, a1.z, a1.w};
                const float b[8] = {b0.x, b0.y, b0.z, b0.w, b1.x, b1.y, b1.z, b1.w};
#pragma unroll
                for (int i = 0; i < 8; ++i)
#pragma unroll
                    for (int j = 0; j < 8; ++j) acc[i][j] = fmaf(a[i], b[j], acc[i][j]);
            }
            __syncthreads();
        }
#pragma unroll
        for (int i = 0; i < 8; ++i) epi(mt * 128 + ty * 8 + i, nt * 256 + tx * 4, (f32x4){acc[i][0], acc[i][1], acc[i][2], acc[i][3]}, (f32x4){acc[i][4], acc[i][5], acc[i][6], acc[i][7]});
    }
}

__device__ __forceinline__ void prep_seg(bf16* seg, int width, int lane, bool do_norm, const float* gain, bool do_rope, const float* cs, const float* sn, int dim  ) {
    if (lane * 4 >= width) return;
    const v2u raw = *(const v2u*)(seg + 4 * lane);
    float v[4] = {bflo(raw.x), bfhi(raw.x), bflo(raw.y), bfhi(raw.y)};
    const int d0 = (4 * lane) % dim;
    if (do_norm) {
        float ss = v[0] * v[0] + v[1] * v[1] + v[2] * v[2] + v[3] * v[3];
        ss += __shfl_xor(ss, 1); ss += __shfl_xor(ss, 2); ss += __shfl_xor(ss, 4); ss += __shfl_xor(ss, 8);
        const float rstd = 1.0f / sqrtf(ss * (1.f / 64.f) + EPS);
#pragma unroll
        for (int i = 0; i < 4; ++i) v[i] = v[i] * rstd * gain[d0 + i];
    }
    if (do_rope) {
        const int pi = d0 >> 1;
        const float c0 = cs[pi], s0 = sn[pi], c1 = cs[pi + 1], s1 = sn[pi + 1];
        const float a0 = v[0] * c0 - v[1] * s0, a1 = v[0] * s0 + v[1] * c0, a2 = v[2] * c1 - v[3] * s1, a3 = v[2] * s1 + v[3] * c1;
        v[0] = a0; v[1] = a1; v[2] = a2; v[3] = a3;
    }
    v2u w; w.x = pk2(v[0], v[1]); w.y = pk2(v[2], v[3]);
    *(v2u*)(seg + 4 * lane) = w;
}
__device__ __forceinline__ void ph_prep(Frame& F, int l) {
    const int gw = F.bid * NWAVES + F.wave, NGW = F.G * NWAVES;
    FOR_ROWS(F, row, MT) {
        bf16* pr = F.p() + (size_t)row * PROJ;
        const bool lat = row < ML; const int t = lat ? row % SEQ : 0;
        const float *ca = F.cosA() + t * 32, *sa = F.sinA() + t * 32, *cb = F.cosB() + t * 16, *sb = F.sinB() + t * 16;
        {
            const v2u raw = *(const v2u*)(pr + 4 * F.lane);
            float v[4] = {bflo(raw.x), bfhi(raw.x), bflo(raw.y), bfhi(raw.y)};
            const v2u rawk = *(const v2u*)(pr + 256 + 4 * (F.lane & 31));
            float kx[4] = {bflo(rawk.x), bfhi(rawk.x), bflo(rawk.y), bfhi(rawk.y)};
            float ss = v[0] * v[0] + v[1] * v[1] + v[2] * v[2] + v[3] * v[3];
            float sk = kx[0] * kx[0] + kx[1] * kx[1] + kx[2] * kx[2] + kx[3] * kx[3];
            ss += __shfl_xor(ss, 1); ss += __shfl_xor(ss, 2); ss += __shfl_xor(ss, 4); ss += __shfl_xor(ss, 8);
            sk += __shfl_xor(sk, 1); sk += __shfl_xor(sk, 2); sk += __shfl_xor(sk, 4); sk += __shfl_xor(sk, 8);
            const float rq = 1.0f / sqrtf(ss * (1.f / 64.f) + EPS), rk = 1.0f / sqrtf(sk * (1.f / 64.f) + EPS);
            const int d0 = (4 * F.lane) & 63;
            const float* gq = F.q_gain_a() + l * 64 + d0; const float* gk = F.k_gain_a() + l * 64 + d0;
#pragma unroll
            for (int i = 0; i < 4; ++i) { v[i] = v[i] * rq * gq[i]; kx[i] = kx[i] * rk * gk[i]; }
            if (lat) { const int pi = d0 >> 1; const float c0 = ca[pi], s0 = sa[pi], c1 = ca[pi + 1], s1 = sa[pi + 1];
                float a0 = v[0] * c0 - v[1] * s0, a1 = v[0] * s0 + v[1] * c0, a2 = v[2] * c1 - v[3] * s1, a3 = v[2] * s1 + v[3] * c1;
                v[0] = a0; v[1] = a1; v[2] = a2; v[3] = a3;
                a0 = kx[0] * c0 - kx[1] * s0; a1 = kx[0] * s0 + kx[1] * c0; a2 = kx[2] * c1 - kx[3] * s1; a3 = kx[2] * s1 + kx[3] * c1;
                kx[0] = a0; kx[1] = a1; kx[2] = a2; kx[3] = a3; }
            v2u w; w.x = pk2(v[0], v[1]); w.y = pk2(v[2], v[3]); *(v2u*)(pr + 4 * F.lane) = w;
            if (F.lane < 32) { v2u wk; wk.x = pk2(kx[0], kx[1]); wk.y = pk2(kx[2], kx[3]); *(v2u*)(pr + 256 + 4 * F.lane) = wk; }
        }
        if (lat) {
            prep_seg(pr + 512, 256, F.lane, false, nullptr, true, cb, sb, 32);
            prep_seg(pr + 768, 256, F.lane, false, nullptr, true, cb, sb, 32);
            prep_seg(pr + 1280, 256, F.lane, false, nullptr, true, ca, sa, 64);
            prep_seg(pr + 1536, 128, F.lane, false, nullptr, true, ca, sa, 64);
        }
    }
}

__device__ __forceinline__ void ldrow64(const bf16* p, float* f) {
#pragma unroll
    for (int i = 0; i < 8; ++i) ld8(p + 8 * i, f + 8 * i);
}
template <int MIX>
__device__ __forceinline__ void attn_naive_q(Frame& F, int l, int b, int h, int qi, bool isctx) {
    const bf16* P = F.p();
    const size_t qrow = isctx ? (size_t)(ML + b * LC + qi) : (size_t)(b * SEQ + qi);
    const int kvh = (MIX == 0 || MIX == 2) ? (h >> 1) : h;
    const int qo = QOFF_(MIX) + h * 64, ko = KOFF_(MIX) + kvh * 64, vo = VOFF_(MIX) + kvh * 64;
    float q[64]; ldrow64(P + qrow * PROJ + qo, q);
    float o[64];
#pragma unroll
    for (int d = 0; d < 64; ++d) o[d] = 0.f;
    const size_t crow0 = (size_t)(ML + b * LC), lrow0 = (size_t)b * SEQ;
    if (MIX != 1) {
#pragma unroll
        for (int d = 0; d < 64; ++d) q[d] *= 0.125f;
        float m = -INFINITY, ls = 0.f;
        if (MIX == 2) { m = F.sink()[l * 4 + h]; ls = 1.f; }
        const int r_ = qi / GRIDW, cq_ = qi % GRIDW;
        int rs_ = r_ - 4; rs_ = rs_ < 0 ? 0 : (rs_ > 24 ? 24 : rs_);
        int cs_ = cq_ - 8; cs_ = cs_ < 0 ? 0 : (cs_ > 48 ? 48 : cs_);
        const int nk = LC + (isctx ? 0 : (MIX == 0 ? SEQ : (MIX == 2 ? 257 : 128)));
        for (int j = 0; j < nk; ++j) {
            size_t krow = crow0 + j; float bias = 0.f; bool valid = true;
            if (j >= LC) { const int jj = j - LC;
                if (MIX == 0) krow = lrow0 + jj;
                if (MIX == 2) { const int t2 = qi - 128 + jj; valid = (t2 >= 0 && t2 < SEQ); krow = lrow0 + (valid ? t2 : 0); }
                if (MIX == 3) { const int kr = jj >> 4, w = cs_ + (jj & 15); const int ri = rs_ + kr - r_ + 7; int ci = w - cq_ + 15; ci = ci < 0 ? 0 : (ci > 30 ? 30 : ci);
                    krow = lrow0 + (size_t)(rs_ + kr) * GRIDW + w; bias = F.rpb()[((l * 4 + h) * 15 + ri) * 31 + ci]; } }
            if (valid) {
                float s = 0.f;
#pragma unroll
                for (int c8 = 0; c8 < 8; ++c8) { float kf[8]; ld8(P + krow * PROJ + ko + 8 * c8, kf);
#pragma unroll
                    for (int i = 0; i < 8; ++i) s = fmaf(q[8 * c8 + i], kf[i], s);
                    if (c8 & 1) asm volatile("" ::: "memory"); }
                s += bias;
                const float mn = fmaxf(m, s), cr = expf(m - mn), pe = expf(s - mn);
                ls = ls * cr + pe;
#pragma unroll
                for (int c8 = 0; c8 < 8; ++c8) { float kf[8]; ld8(P + krow * PROJ + vo + 8 * c8, kf);
#pragma unroll
                    for (int i = 0; i < 8; ++i) o[8 * c8 + i] = o[8 * c8 + i] * cr + pe * kf[i];
                    if (c8 & 1) asm volatile("" ::: "memory"); }
                m = mn;
            }
        }
        const float inv = 1.f / ls;
#pragma unroll
        for (int d = 0; d < 64; ++d) o[d] *= inv;
    } else {
        const float sc = 0.17677669529663687f;
#pragma unroll
        for (int d = 0; d < 64; ++d) q[d] *= sc;
        float m1 = -INFINITY, l1 = 0.f, m2 = -INFINITY, l2 = 0.f;
        const int nk = isctx ? LC : LC + SEQ;
        for (int j = 0; j < nk; ++j) { const size_t krow = j < LC ? crow0 + j : lrow0 + (j - LC);
            float s1 = 0.f, s2 = 0.f;
#pragma unroll
            for (int c8 = 0; c8 < 4; ++c8) { float kf[8], kg[8]; ld8(P + krow * PROJ + ko + 8 * c8, kf); ld8(P + krow * PROJ + ko + 32 + 8 * c8, kg);
#pragma unroll
                for (int i = 0; i < 8; ++i) { s1 = fmaf(q[8 * c8 + i], kf[i], s1); s2 = fmaf(q[32 + 8 * c8 + i], kg[i], s2); }
                asm volatile("" ::: "memory"); }
            float mn = fmaxf(m1, s1); l1 = l1 * expf(m1 - mn) + expf(s1 - mn); m1 = mn;
            mn = fmaxf(m2, s2); l2 = l2 * expf(m2 - mn) + expf(s2 - mn); m2 = mn; }
        float d1 = 0.f, d2 = 0.f;
        for (int i = 0; i < 32; ++i) { d1 += F.lam_q1()[l * 32 + i] * F.lam_k1()[l * 32 + i]; d2 += F.lam_q2()[l * 32 + i] * F.lam_k2()[l * 32 + i]; }
        const float lam_init = 0.8f - 0.6f * expf(-0.3f * (float)l);
        const float lam = expf(d1) - expf(d2) + lam_init;
        const float i1 = 1.f / l1, i2 = lam / l2;
        for (int j = 0; j < nk; ++j) { const size_t krow = j < LC ? crow0 + j : lrow0 + (j - LC);
            float s1 = 0.f, s2 = 0.f;
#pragma unroll
            for (int c8 = 0; c8 < 4; ++c8) { float kf[8], kg[8]; ld8(P + krow * PROJ + ko + 8 * c8, kf); ld8(P + krow * PROJ + ko + 32 + 8 * c8, kg);
#pragma unroll
                for (int i = 0; i < 8; ++i) { s1 = fmaf(q[8 * c8 + i], kf[i], s1); s2 = fmaf(q[32 + 8 * c8 + i], kg[i], s2); }
                asm volatile("" ::: "memory"); }
            const float a = expf(s1 - m1) * i1 - expf(s2 - m2) * i2;
#pragma unroll
            for (int c8 = 0; c8 < 8; ++c8) { float kf[8]; ld8(P + krow * PROJ + vo + 8 * c8, kf);
#pragma unroll
                for (int i = 0; i < 8; ++i) o[8 * c8 + i] = fmaf(a, kf[i], o[8 * c8 + i]);
                if (c8 & 1) asm volatile("" ::: "memory"); } }
        float ss = 0.f;
#pragma unroll
        for (int d = 0; d < 64; ++d) ss += o[d] * o[d];
        const float rstd = 1.0f / sqrtf(ss * (1.f / 64.f) + EPS) * (1.f - lam_init);
#pragma unroll
        for (int d = 0; d < 64; ++d) o[d] = o[d] * rstd * F.subln()[l * 64 + d];
    }
    bf16* orow = F.o() + qrow * D + MIX * 256 + h * 64;
#pragma unroll
    for (int d = 0; d < 64; d += 8) { v4u w; w.x = pk2(o[d], o[d + 1]); w.y = pk2(o[d + 2], o[d + 3]); w.z = pk2(o[d + 4], o[d + 5]); w.w = pk2(o[d + 6], o[d + 7]); *(v4u*)(orow + d) = w; }
}
__device__ __forceinline__ void ph_attn_naive(Frame& F, int l) {
    const int nitems = 512 + (l == 0 ? 128 : 0);
    for (int it = F.bid; it < nitems; it += F.G) {
        if (it < 512) { const int mo = it / 128, r = it % 128, b = r / 16, h = (r / 4) % 4, ch = r % 4, qi = ch * 512 + F.tid;
            if (mo == 0) attn_naive_q<1>(F, l, b, h, qi, false); else if (mo == 1) attn_naive_q<0>(F, l, b, h, qi, false);
            else if (mo == 2) attn_naive_q<3>(F, l, b, h, qi, false); else attn_naive_q<2>(F, l, b, h, qi, false); }
        else { const int r = it - 512, mix = r / 32, b = (r / 4) % 8, h = r % 4;
            if (F.tid < LC) { if (mix == 0) attn_naive_q<0>(F, l, b, h, F.tid, true); else if (mix == 1) attn_naive_q<1>(F, l, b, h, F.tid, true);
                else if (mix == 2) attn_naive_q<2>(F, l, b, h, F.tid, true); else attn_naive_q<3>(F, l, b, h, F.tid, true); } }
    }
}


namespace fa {
typedef float f32x16 __attribute__((ext_vector_type(16)));
typedef short s16x4 __attribute__((ext_vector_type(4)));
typedef short v4i16_t __attribute__((ext_vector_type(4)));
constexpr float LOG2E = 1.4426950408889634f, NEG = -1e30f;
constexpr int K_OFF = 0, V_OFF = 3 * 8192;
constexpr int BT_OFF = V_OFF + 2 * 8192;
constexpr int Q_OFF = BT_OFF + 2048;
constexpr int DB_OFF = Q_OFF + 32768;
constexpr int DP_OFF = DB_OFF + 15 * 512;
__device__ __forceinline__ int crow(int r, int hi) { return (r & 3) + 8 * (r >> 2) + 4 * hi; }
typedef float f32x2_t __attribute__((ext_vector_type(2))); typedef __bf16 bf16x2_t __attribute__((ext_vector_type(2)));
__device__ __forceinline__ unsigned cvtpk(float lo, float hi) { f32x2_t v = {lo, hi}; bf16x2_t b = __builtin_convertvector(v, bf16x2_t); return __builtin_bit_cast(unsigned, b); }
__device__ __forceinline__ s16x4 vtr(const LAS unsigned char* p) { return __builtin_bit_cast(s16x4, __builtin_amdgcn_ds_read_tr16_b64_v4i16((LAS v4i16_t*)p)); }
__device__ __forceinline__ float xhalf_max(float v) { return fmaxf(v, __shfl_xor(v, 32)); }
__device__ __forceinline__ float swap32_max(float v) {
    unsigned a = __builtin_bit_cast(unsigned, v), b = a; asm volatile("" : "+v"(b));
    const auto rr = __builtin_amdgcn_permlane32_swap(a, b, false, false);
    return fmaxf(__builtin_bit_cast(float, rr[0]), __builtin_bit_cast(float, rr[1]));
}

struct State { float m, l; f32x16 o[2]; };

constexpr float THR = 8.0f;
__device__ __forceinline__ void softmax_pv(State& st, f32x16& s0, f32x16& s1, float ref_used, bool first, const LAS unsigned char* Vb, int vb0) {
    float ta = fmaxf(fmaxf(s0[0], s0[1]), s1[0]), tb = fmaxf(fmaxf(s0[2], s0[3]), s1[1]);
    ta = fmaxf(fmaxf(ta, s1[2]), s1[3]);
#pragma unroll
    for (int r = 4; r < 16; r += 4) { ta = fmaxf(fmaxf(ta, s0[r]), s0[r + 1]); tb = fmaxf(fmaxf(tb, s0[r + 2]), s0[r + 3]); ta = fmaxf(fmaxf(ta, s1[r]), s1[r + 1]); tb = fmaxf(fmaxf(tb, s1[r + 2]), s1[r + 3]); }
    float tm = fmaxf(ta, tb);
    tm = swap32_max(tm);
    const float adj = st.m - ref_used;
    tm -= adj;
    if (first || __any(tm > THR) || __any(adj != 0.f)) {
        const float dl = first ? tm : fmaxf(tm, 0.f), sub = adj + dl;
        st.m += dl;
        const float al = __builtin_amdgcn_exp2f(-dl);
        st.l *= al;
#pragma unroll
        for (int r = 0; r < 16; ++r) { s0[r] -= sub; s1[r] -= sub; st.o[0][r] *= al; st.o[1][r] *= al; }
    }
    float ps0 = 0.f, ps1 = 0.f;
#pragma unroll
    for (int r = 0; r < 16; ++r) { s0[r] = __builtin_amdgcn_exp2f(s0[r]); s1[r] = __builtin_amdgcn_exp2f(s1[r]); ps0 += s0[r]; ps1 += s1[r]; }
    st.l += ps0 + ps1;
#pragma unroll
    for (int kb = 0; kb < 2; ++kb)
#pragma unroll
        for (int sh = 0; sh < 2; ++sh) {
            const f32x16& sv = kb ? s1 : s0;
            v4u pw; pw.x = cvtpk(sv[8 * sh + 0], sv[8 * sh + 1]); pw.y = cvtpk(sv[8 * sh + 2], sv[8 * sh + 3]); pw.z = cvtpk(sv[8 * sh + 4], sv[8 * sh + 5]); pw.w = cvtpk(sv[8 * sh + 6], sv[8 * sh + 7]);
            const bf16x8 pf = __builtin_bit_cast(bf16x8, pw);
            const int ks = kb * 2 + sh;
#pragma unroll
            for (int db = 0; db < 2; ++db) {
                const s16x4 lo = vtr(Vb + vb0 + db * 4096 + ks * 1024), hv = vtr(Vb + vb0 + db * 4096 + ks * 1024 + 512);
                const bf16x8 vf = (bf16x8){lo[0], lo[1], lo[2], lo[3], hv[0], hv[1], hv[2], hv[3]};
                st.o[db] = __builtin_amdgcn_mfma_f32_32x32x16_bf16(vf, pf, st.o[db], 0, 0, 0);
            }
        }
}

template <int MIX, int KS0, int NKS>
__device__ __forceinline__ void qk_tile(f32x16& s0, f32x16& s1, float ref, const LAS unsigned char* Kb, const bf16x8 (&qf)[4], const LAS unsigned char* qlds, int r32, int hi,
                                        bool lat, int j, int qpos, int rq, int cq, int csq, const LAS unsigned char* lds, int bt_off) {
#define FA_QF(ks) ((MIX == 1) ? *(const LAS bf16x8*)(qlds + (ks) * 1024) : qf[ks])
    { f32x16 negm;
#pragma unroll
      for (int r = 0; r < 16; ++r) negm[r] = -ref;
      s0 = negm; s1 = negm; }
#pragma unroll
    for (int kk = 0; kk < NKS; ++kk) { const int ks = KS0 + kk;
        const bf16x8 k0 = *(const LAS bf16x8*)(Kb + (2 * ks + hi) * 1024 + r32 * 16), k1 = *(const LAS bf16x8*)(Kb + (2 * ks + hi) * 1024 + 512 + r32 * 16);
        const bf16x8 qv = FA_QF(ks);
        s0 = __builtin_amdgcn_mfma_f32_32x32x16_bf16(k0, qv, s0, 0, 0, 0);
        s1 = __builtin_amdgcn_mfma_f32_32x32x16_bf16(k1, qv, s1, 0, 0, 0); }
    if (MIX == 2 && lat) {
#pragma unroll
        for (int r = 0; r < 16; ++r) { const int kp = 64 * j + crow(r, hi), d0 = kp - qpos, d1 = kp + 32 - qpos;
            s0[r] = (d0 <= 128 && d0 >= -128) ? s0[r] : NEG; s1[r] = (d1 <= 128 && d1 >= -128) ? s1[r] : NEG; }
    } else if (MIX == 3 && lat) {
        const LAS unsigned char* pb = lds + DB_OFF + (j - rq + 7) * 512 + (63 - cq + 4 * hi) * 4;
        const LAS unsigned char* pp = lds + DP_OFF + (48 - csq + 4 * hi) * 4;
#pragma unroll
        for (int r = 0; r < 16; ++r) { const int wc4 = ((r & 3) + 8 * (r >> 2)) * 4;
            s0[r] += *(const LAS float*)(pb + wc4) + *(const LAS float*)(pp + wc4);
            s1[r] += *(const LAS float*)(pb + wc4 + 128) + *(const LAS float*)(pp + wc4 + 128); }
    }
}


#define FA_SB() __builtin_amdgcn_sched_barrier(0)
__device__ __forceinline__ float tile_max(const f32x16& s0, const f32x16& s1) {
    float ta = fmaxf(fmaxf(s0[0], s0[1]), s1[0]), tb = fmaxf(fmaxf(s0[2], s0[3]), s1[1]);
    ta = fmaxf(fmaxf(ta, s1[2]), s1[3]);
#pragma unroll
    for (int r = 4; r < 16; r += 4) { ta = fmaxf(fmaxf(ta, s0[r]), s0[r + 1]); tb = fmaxf(fmaxf(tb, s0[r + 2]), s0[r + 3]); ta = fmaxf(fmaxf(ta, s1[r]), s1[r + 1]); tb = fmaxf(fmaxf(tb, s1[r + 2]), s1[r + 3]); }
    float tm = fmaxf(ta, tb);
    return swap32_max(tm);
}
__device__ __forceinline__ void decide(State& st, f32x16& s0, f32x16& s1, float tm, bool first) {
    if (first || __any(tm > THR)) {
        const float dl = first ? tm : fmaxf(tm, 0.f);
        st.m += dl;
        const float al = __builtin_amdgcn_exp2f(-dl);
        st.l *= al;
#pragma unroll
        for (int r = 0; r < 16; ++r) { s0[r] -= dl; s1[r] -= dl; st.o[0][r] *= al; st.o[1][r] *= al; }
    }
}
template <int MIX>
__device__ __forceinline__ void apply_mask(f32x16& s0, f32x16& s1, int hi, int j, int qpos, int rq, int cq, int csq, const LAS unsigned char* lds, int bt_off) {
    if (MIX == 2) {
#pragma unroll
        for (int r = 0; r < 16; ++r) { const int kp = 64 * j + crow(r, hi), d0 = kp - qpos, d1 = kp + 32 - qpos;
            s0[r] = (d0 <= 128 && d0 >= -128) ? s0[r] : NEG; s1[r] = (d1 <= 128 && d1 >= -128) ? s1[r] : NEG; }
    } else if (MIX == 3) {
        const LAS unsigned char* pb = lds + DB_OFF + (j - rq + 7) * 512 + (63 - cq + 4 * hi) * 4;
        const LAS unsigned char* pp = lds + DP_OFF + (48 - csq + 4 * hi) * 4;
#pragma unroll
        for (int r = 0; r < 16; ++r) { const int wc4 = ((r & 3) + 8 * (r >> 2)) * 4;
            s0[r] += *(const LAS float*)(pb + wc4) + *(const LAS float*)(pp + wc4);
            s1[r] += *(const LAS float*)(pb + wc4 + 128) + *(const LAS float*)(pp + wc4 + 128); }
    }
}
template <int MIX, int KS0, int NKS, bool HASNEXT, bool MASKNEXT>
__device__ __forceinline__ void fused_step(State& st, f32x16& c0, f32x16& c1, f32x16& n0, f32x16& n1, float nref, float& ntm,
                                           const LAS unsigned char* Kn, const bf16x8 (&qf)[4], const LAS unsigned char* qlds, const LAS unsigned char* Vb, int vb0, int r32, int hi,
                                           int j, int qpos, int rq, int cq, int csq, const LAS unsigned char* lds, int bt_off) {
    bf16x8 kA0 = {}, kA1 = {}, kB0 = {}, kB1 = {};
#define FA_KLD(kk, X0, X1) do { X0 = *(const LAS bf16x8*)(Kn + (2 * (KS0 + (kk)) + hi) * 1024 + r32 * 16); X1 = *(const LAS bf16x8*)(Kn + (2 * (KS0 + (kk)) + hi) * 1024 + 512 + r32 * 16); } while (0)
    if (HASNEXT) {
        FA_KLD(0, kA0, kA1);
        f32x16 negm;
#pragma unroll
        for (int r = 0; r < 16; ++r) negm[r] = -nref;
        n0 = negm; n1 = negm;
    }
    float ps0 = 0.f, ps1 = 0.f;
    s16x4 va[4], vb[4];
    bf16x8 qpre[2] = {};
    if (HASNEXT && MIX == 1) { qpre[0] = FA_QF(KS0); qpre[1] = FA_QF(KS0 + 1); }
    __builtin_amdgcn_s_setprio(1);
    FA_SB();
#pragma unroll
    for (int g = 0; g < 4; ++g) {
        const bool mm = HASNEXT && (NKS == 4 || (g & 1) == 0);
        const int kk = (NKS == 4) ? g : (g >> 1);
        const bool nextk = HASNEXT && mm && (kk + 1 < NKS);
        bf16x8 qv = {};
        if (mm) { qv = (MIX == 1) ? qpre[kk & 1] : FA_QF(KS0 + kk); n0 = __builtin_amdgcn_mfma_f32_32x32x16_bf16((kk & 1) ? kB0 : kA0, qv, n0, 0, 0, 0); }
        FA_SB();
        if (nextk) { if (kk & 1) FA_KLD(kk + 1, kA0, kA1); else FA_KLD(kk + 1, kB0, kB1); }
#pragma unroll
        for (int i = 0; i < 4; ++i) { c0[4 * g + i] = __builtin_amdgcn_exp2f(c0[4 * g + i]); ps0 += c0[4 * g + i]; }
        FA_SB();
        if (mm) n1 = __builtin_amdgcn_mfma_f32_32x32x16_bf16((kk & 1) ? kB1 : kA1, qv, n1, 0, 0, 0);
        FA_SB();
        if (g == 3) {
#pragma unroll
            for (int q = 0; q < 4; ++q) va[q] = vtr(Vb + vb0 + (q >> 1) * 4096 + (q & 1) * 512);
        }
#pragma unroll
        for (int i = 0; i < 4; ++i) { c1[4 * g + i] = __builtin_amdgcn_exp2f(c1[4 * g + i]); ps1 += c1[4 * g + i]; }
        FA_SB();
    }
#undef FA_KLD
    st.l += ps0 + ps1;
    if (HASNEXT && MASKNEXT) apply_mask<MIX>(n0, n1, hi, j, qpos, rq, cq, csq, lds, bt_off);
    float pm[4] = {0.f, 0.f, 0.f, 0.f};
    FA_SB();
#pragma unroll
    for (int ks = 0; ks < 4; ++ks) {
        const f32x16& sv = (ks >> 1) ? c1 : c0; const int sh = ks & 1;
        v4u pw; pw.x = cvtpk(sv[8 * sh + 0], sv[8 * sh + 1]); pw.y = cvtpk(sv[8 * sh + 2], sv[8 * sh + 3]); pw.z = cvtpk(sv[8 * sh + 4], sv[8 * sh + 5]); pw.w = cvtpk(sv[8 * sh + 6], sv[8 * sh + 7]);
        const bf16x8 pf = __builtin_bit_cast(bf16x8, pw);
        s16x4 (&vc)[4] = (ks & 1) ? vb : va; s16x4 (&vn)[4] = (ks & 1) ? va : vb;
        if (true) { if (ks < 3) {
#pragma unroll
            for (int q = 0; q < 4; ++q) vn[q] = vtr(Vb + vb0 + (q >> 1) * 4096 + (ks + 1) * 1024 + (q & 1) * 512); } }
        else if (ks > 0) {
#pragma unroll
            for (int q = 0; q < 4; ++q) va[q] = vtr(Vb + vb0 + (q >> 1) * 4096 + ks * 1024 + (q & 1) * 512); }
        st.o[0] = __builtin_amdgcn_mfma_f32_32x32x16_bf16((bf16x8){vc[0][0], vc[0][1], vc[0][2], vc[0][3], vc[1][0], vc[1][1], vc[1][2], vc[1][3]}, pf, st.o[0], 0, 0, 0);
        FA_SB();
        float pma = 0.f;
        if (HASNEXT) pma = fmaxf(fmaxf(n0[4 * ks], n0[4 * ks + 1]), fmaxf(n0[4 * ks + 2], n0[4 * ks + 3]));
        FA_SB();
        st.o[1] = __builtin_amdgcn_mfma_f32_32x32x16_bf16((bf16x8){vc[2][0], vc[2][1], vc[2][2], vc[2][3], vc[3][0], vc[3][1], vc[3][2], vc[3][3]}, pf, st.o[1], 0, 0, 0);
        FA_SB();
        if (HASNEXT) pm[ks] = fmaxf(pma, fmaxf(fmaxf(n1[4 * ks], n1[4 * ks + 1]), fmaxf(n1[4 * ks + 2], n1[4 * ks + 3])));
        FA_SB();
    }
    __builtin_amdgcn_s_setprio(0);
    if (HASNEXT) {
        float tm = fmaxf(fmaxf(pm[0], pm[1]), fmaxf(pm[2], pm[3]));
        ntm = swap32_max(tm);
    }
}

template <int MIX>
__device__ __forceinline__ void attn_unit(Frame& F, int l, int b, int h, int qt, bool isctx) {
    int tid_ = threadIdx.x; asm volatile("" : "+v"(tid_));
    const int tid = tid_, lane = tid & 63, r32 = lane & 31, hi = lane >> 5, wid = __builtin_amdgcn_readfirstlane(tid >> 6);
    const bf16* P = F.p();
    const int kvh = (MIX == 0 || MIX == 2) ? (h >> 1) : h;
    const int qo = QOFF_(MIX) + h * 64, ko = KOFF_(MIX) + kvh * 64, vo = VOFF_(MIX) + kvh * 64;
    const int qbase = isctx ? 0 : qt * 256;
    const int qpos = qbase + wid * 32 + r32;
    const size_t qrow = (size_t)(isctx ? ML + b * LC : b * SEQ) + qpos;
    const float c2 = (MIX == 1 ? 0.17677669529663687f : 0.125f) * LOG2E;
    bf16x8 qf[4];
    v4u qraw[4];
#pragma unroll
    for (int ks = 0; ks < 4; ++ks) qraw[ks] = *(const v4u*)(P + qrow * PROJ + qo + 16 * ks + 8 * hi);
    const LAS unsigned char* qlds = F.lds + Q_OFF + wid * 4096 + lane * 16;
    int jlo = 0, jhi = 0;
    if (!isctx) {
        if (MIX == 0 || MIX == 1) { jlo = 0; jhi = 32; }
        if (MIX == 2) { jlo = (qbase - 128) / 64; jlo = jlo < 0 ? 0 : jlo; jhi = (qbase + 256 + 128) / 64; jhi = jhi > 32 ? 32 : jhi; }
        if (MIX == 3) { const int r0 = qbase / 64; int a = r0 - 4; a = a < 0 ? 0 : (a > 24 ? 24 : a); int c = r0 + 3 - 4; c = c < 0 ? 0 : (c > 24 ? 24 : c); jlo = a; jhi = c + 8; }
    }
    const int NT = 4 + (jhi - jlo);
    const LAS unsigned char* lds = F.lds;
    if (MIX == 3 && !isctx) {
        __syncthreads();
        LAS float* bt = (LAS float*)(F.lds + DB_OFF);
        {
            float tb_[4];
#pragma unroll
            for (int q = 0; q < 4; ++q) { const int i = tid + NTHR * q, ri = i >> 7, dl = (i & 127) - 63; tb_[q] = (i < 15 * 128 && dl >= -15 && dl <= 15) ? F.rpb()[((l * 4 + h) * 15 + ri) * 31 + dl + 15] * LOG2E : 0.f; }
#pragma unroll
            for (int q = 0; q < 4; ++q) { const int i = tid + NTHR * q; if (i < 15 * 128) bt[i] = tb_[q]; }
        }
        LAS float* pt = (LAS float*)(F.lds + DP_OFF);
        if (tid < 128) pt[tid] = (tid >= 48 && tid < 64) ? 0.f : NEG;
    }
    const size_t crow0 = (size_t)(ML + b * LC), lrow0 = (size_t)b * SEQ;
    const size_t ksrc_off = (size_t)lane * PROJ + ko + wid * 8;
    const size_t vsrc_off = (size_t)(16 * (wid & 3) + (lane >> 2)) * PROJ + vo + (wid >> 2) * 32 + (lane & 3) * 8;
#define FA_TILE_ROW0(t) ((t) < 4 ? crow0 + 64 * (t) : lrow0 + 64 * (size_t)(jlo + (t) - 4))
#define FA_DMA_K(t, slot) __builtin_amdgcn_global_load_lds((const unsigned*)(P + FA_TILE_ROW0(t) * PROJ + ksrc_off), (LAS unsigned*)(F.lds + K_OFF + (slot) * 8192 + wid * 1024), 16, 0, 0)
#define FA_DMA_V(t, slot) __builtin_amdgcn_global_load_lds((const unsigned*)(P + FA_TILE_ROW0(t) * PROJ + vsrc_off), (LAS unsigned*)(F.lds + V_OFF + (slot) * 8192 + wid * 1024), 16, 0, 0)
#define FA_NEED(t) ((MIX == 2 && (t) >= 4) ? ((64 * (jlo + (t) - 4) <= qw0 + 31 + 128) && (64 * (jlo + (t) - 4) + 63 >= qw0 - 128)) : (MIX == 3 && (t) >= 4) ? ((jlo + (t) - 4 >= rsw) && (jlo + (t) - 4 < rsw + 8)) : true)
#define FA_QK(S0, S1, REF, t, slot, KS0, NKS) qk_tile<MIX, KS0, NKS>(S0, S1, REF, lds + K_OFF + (slot) * 8192, qf, qlds, r32, hi, (t) >= 4, jlo + (t) - 4, qpos, rq, cq, csq, lds, BT_OFF)
#define FA_NEXT3(k) ((k) == 2 ? 0 : (k) + 1)
    const int vb0 = ((lane >> 4) & 1) * 32 + (lane & 3) * 8 + (4 * hi + ((lane & 15) >> 2)) * 64;
    State st, st2;
    st.m = 0.f; st.l = 0.f; st.o[0] = f32x16{}; st.o[1] = f32x16{};
    st2.m = 0.f; st2.l = 0.f; st2.o[0] = f32x16{}; st2.o[1] = f32x16{};
    if (MIX == 2) { st.m = F.sink()[l * 4 + h] * LOG2E; st.l = hi == 0 ? 1.f : 0.f; }
    const bool has_ref = (MIX == 2);
    const int qw0 = qbase + wid * 32;
    const int rq = qpos / GRIDW, cq = qpos % GRIDW;
    int csq = cq - 8; csq = csq < 0 ? 0 : (csq > 48 ? 48 : csq);
    int rsw = (qw0 / GRIDW) - 4; rsw = rsw < 0 ? 0 : (rsw > 24 ? 24 : rsw);
    asm volatile("s_waitcnt lgkmcnt(0)" ::: "memory"); __builtin_amdgcn_s_barrier(); asm volatile("" ::: "memory");
    FA_DMA_K(0, 0); FA_DMA_V(0, 0); FA_DMA_K(1, 1);
#pragma unroll
    for (int ks = 0; ks < 4; ++ks) { const v4u raw = qraw[ks];
        v4u sc; sc.x = cvtpk(bflo(raw.x) * c2, bfhi(raw.x) * c2); sc.y = cvtpk(bflo(raw.y) * c2, bfhi(raw.y) * c2); sc.z = cvtpk(bflo(raw.z) * c2, bfhi(raw.z) * c2); sc.w = cvtpk(bflo(raw.w) * c2, bfhi(raw.w) * c2);
        qf[ks] = __builtin_bit_cast(bf16x8, sc); }
    if (MIX == 1) {
#pragma unroll
        for (int ks = 0; ks < 4; ++ks) *(LAS bf16x8*)(F.lds + Q_OFF + wid * 4096 + lane * 16 + ks * 1024) = qf[ks];
    }
    asm volatile("s_waitcnt vmcnt(0)" ::: "memory");
    __syncthreads();
    int kq = 0;
#define FA_STEP(KS0, NKS, HASNEXT, MASKNEXT, ST, C0, C1, N0, N1, NREF, NTM, tn, kslot, tv) \
    fused_step<MIX, KS0, NKS, HASNEXT, MASKNEXT>(ST, C0, C1, N0, N1, NREF, NTM, lds + K_OFF + (kslot) * 8192, qf, qlds, lds + V_OFF + ((tv) & 1) * 8192, vb0, r32, hi, jlo + (tn) - 4, qpos, rq, cq, csq, lds, BT_OFF)
    if (MIX == 3) {
        const bool cvt_on = CVT_ATT && (l == 0) && !isctx && F.G == 256;
        LAS unsigned char* cvb = F.lds + (wid < 4 ? Q_OFF + wid * 8192 : DP_OFF + 512 + (wid - 4) * 8192);
        const int cv0 = CVT_N_IN + CVT_N_OUT + (F.bid * NWAVES + wid) * CVT_ATT_PER_WAVE;
        for (int t = 0; t < NT; ++t) {
            asm volatile("s_waitcnt vmcnt(0)" ::: "memory");
            __syncthreads();
            const int k1 = FA_NEXT3(kq), k2 = FA_NEXT3(k1);
            if (t + 2 < NT) FA_DMA_K(t + 2, k2);
            if (t + 1 < NT) FA_DMA_V(t + 1, (t + 1) & 1);
            if (cvt_on && t <= CVT_ATT_PER_WAVE) cvt_att_step(F, cv0, t, cvb, lane);
            if (FA_NEED(t)) {
                f32x16 c0, c1, n0, n1; float ntm = 0.f;
                FA_QK(c0, c1, st.m, t, kq, 0, 4);
                const float ctm = tile_max(c0, c1);
                decide(st, c0, c1, ctm, t == 0);
                FA_STEP(0, 4, false, false, st, c0, c1, n0, n1, 0.f, ntm, t + 1, k1, t);
            }
            kq = k1;
        }
        if (cvt_on && NT <= CVT_ATT_PER_WAVE) { asm volatile("s_waitcnt vmcnt(0)" ::: "memory"); cvt_att_step(F, cv0, CVT_ATT_PER_WAVE, cvb, lane); }
    } else if (MIX != 1) {
        f32x16 c0, c1, n0, n1; float ctm, ntm = 0.f, nref = 0.f; bool cneed = true, nneed = false;
        FA_QK(c0, c1, st.m, 0, 0, 0, 4);
        ctm = tile_max(c0, c1);
        for (int t = 0; t < NT; ++t) {
            asm volatile("s_waitcnt vmcnt(0)" ::: "memory");
            __syncthreads();
            const int k1 = FA_NEXT3(kq), k2 = FA_NEXT3(k1);
            if (t + 2 < NT) FA_DMA_K(t + 2, k2);
            if (t + 1 < NT) FA_DMA_V(t + 1, (t + 1) & 1);
            nneed = (t + 1 < NT) && FA_NEED(t + 1);
            if (cneed) decide(st, c0, c1, ctm, t == 0 && !has_ref);
            nref = st.m;
            if (cneed && nneed) {
                if (MIX != 0 && t + 1 >= 4) FA_STEP(0, 4, true, true, st, c0, c1, n0, n1, nref, ntm, t + 1, k1, t);
                else FA_STEP(0, 4, true, false, st, c0, c1, n0, n1, nref, ntm, t + 1, k1, t);
            } else if (cneed) {
                FA_STEP(0, 4, false, false, st, c0, c1, n0, n1, nref, ntm, t + 1, k1, t);
            } else if (nneed) {
                FA_QK(n0, n1, nref, t + 1, k1, 0, 4); ntm = tile_max(n0, n1);
            }
            c0 = n0; c1 = n1; ctm = ntm; cneed = nneed; kq = k1;
        }
    } else {
        f32x16 a0, a1, b0, b1; float atm, btm = 0.f;
        FA_QK(a0, a1, st.m, 0, 0, 0, 2);
        atm = tile_max(a0, a1);
        for (int t = 0; t < NT; ++t) {
            asm volatile("s_waitcnt vmcnt(0)" ::: "memory");
            __syncthreads();
            const int k1 = FA_NEXT3(kq), k2 = FA_NEXT3(k1);
            if (t + 2 < NT) FA_DMA_K(t + 2, k2);
            if (t + 1 < NT) FA_DMA_V(t + 1, (t + 1) & 1);
            decide(st, a0, a1, atm, t == 0);
            FA_STEP(2, 2, true, false, st, a0, a1, b0, b1, st2.m, btm, t, kq, t);
            decide(st2, b0, b1, btm, t == 0);
            if (t + 1 < NT) FA_STEP(0, 2, true, false, st2, b0, b1, a0, a1, st.m, atm, t + 1, k1, t);
            else FA_STEP(0, 2, false, false, st2, b0, b1, a0, a1, st.m, atm, t + 1, k1, t);
            kq = k1;
        }
    }
#undef FA_STEP
#undef FA_DMA_K
#undef FA_DMA_V
#undef FA_NEED
#undef FA_QK
#undef FA_NEXT3
#undef FA_TILE_ROW0
    const float lt = st.l + __shfl_xor(st.l, 32);
    const float inv = 1.0f / lt;
    bf16* orow = F.o() + qrow * D + MIX * 256 + h * 64;
    unsigned char* orow8 = (unsigned char*)F.o() + qrow * D + MIX * 256 + h * 64;
    if (MIX != 1) {
#pragma unroll
        for (int db = 0; db < 2; ++db)
#pragma unroll
            for (int g = 0; g < 4; ++g) {
                if constexpr ((FP8_GEMMS & 2) != 0) *(unsigned*)(orow8 + 32 * db + 8 * g + 4 * hi) = pk4_fp8(st.o[db][4 * g] * inv, st.o[db][4 * g + 1] * inv, st.o[db][4 * g + 2] * inv, st.o[db][4 * g + 3] * inv, AS_O);
                else { v2u w; w.x = cvtpk(st.o[db][4 * g] * inv, st.o[db][4 * g + 1] * inv); w.y = cvtpk(st.o[db][4 * g + 2] * inv, st.o[db][4 * g + 3] * inv);
                *(v2u*)(orow + 32 * db + 8 * g + 4 * hi) = w; } }
    } else {
        const float lt2 = st2.l + __shfl_xor(st2.l, 32);
        float d1 = 0.f, d2 = 0.f;
        for (int i = 0; i < 32; ++i) { d1 += F.lam_q1()[l * 32 + i] * F.lam_k1()[l * 32 + i]; d2 += F.lam_q2()[l * 32 + i] * F.lam_k2()[l * 32 + i]; }
        const float lam_init = 0.8f - 0.6f * expf(-0.3f * (float)l);
        const float lam = expf(d1) - expf(d2) + lam_init;
        const float i2 = lam / lt2;
        float ss = 0.f;
#pragma unroll
        for (int db = 0; db < 2; ++db)
#pragma unroll
            for (int r = 0; r < 16; ++r) { const float v = st.o[db][r] * inv - st2.o[db][r] * i2; st.o[db][r] = v; ss += v * v; }
        ss += __shfl_xor(ss, 32);
        const float rstd = 1.0f / sqrtf(ss * (1.f / 64.f) + EPS) * (1.f - lam_init);
#pragma unroll
        for (int db = 0; db < 2; ++db)
#pragma unroll
            for (int g = 0; g < 4; ++g) { const int d0 = 32 * db + 8 * g + 4 * hi; const f32x4 sg = *(const f32x4*)(F.subln() + l * 64 + d0);
                if constexpr ((FP8_GEMMS & 2) != 0) *(unsigned*)(orow8 + d0) = pk4_fp8(st.o[db][4 * g] * rstd * sg.x, st.o[db][4 * g + 1] * rstd * sg.y, st.o[db][4 * g + 2] * rstd * sg.z, st.o[db][4 * g + 3] * rstd * sg.w, AS_O);
                else { v2u w; w.x = cvtpk(st.o[db][4 * g] * rstd * sg.x, st.o[db][4 * g + 1] * rstd * sg.y); w.y = cvtpk(st.o[db][4 * g + 2] * rstd * sg.z, st.o[db][4 * g + 3] * rstd * sg.w);
                *(v2u*)(orow + d0) = w; } }
    }
}
}

__device__ __forceinline__ void ph_attn(Frame& F, int l) {
    const int nunits = 1024 + (l == 0 ? 128 : 0);
    for (int it = F.bid; it < nunits; it += F.G) {
        if (it < 1024) { const int mo = it >> 8, r = it & 255, b = r & 7, h = (r >> 3) & 3, qt = r >> 5;
            if (mo == 0) fa::attn_unit<1>(F, l, b, h, qt, false); else if (mo == 1) fa::attn_unit<0>(F, l, b, h, qt, false);
            else if (mo == 2) fa::attn_unit<3>(F, l, b, h, qt, false); else fa::attn_unit<2>(F, l, b, h, qt, false); }
        else { const int r = it - 1024, mix = r >> 5, b = r & 7, h = (r >> 3) & 3;
            if (mix == 0) fa::attn_unit<0>(F, l, b, h, 0, true); else if (mix == 1) fa::attn_unit<1>(F, l, b, h, 0, true);
            else if (mix == 2) fa::attn_unit<2>(F, l, b, h, 0, true); else fa::attn_unit<3>(F, l, b, h, 0, true); }
    }
}

#define ROW_OF(F, it) ((it) < 8 ? ((F).bid & 7) * SEQ + ((F).bid >> 3) * 8 + (F).wave + 256 * (it) : ML + ((F).bid & 7) * LC + ((F).bid >> 3) * 8 + (F).wave)
constexpr int WRS = D + 4;
template <int L>
__device__ __forceinline__ void ph_n2(Frame& F) {
    constexpr int l = L;
    LAS float* wr = (LAS float*)F.lds;
    {
        const float* wsrc = F.w_router() + (size_t)l * D * NE;
        float tv[32];
#pragma unroll
        for (int q = 0; q < 16; ++q) { const int p = F.tid + NTHR * q, e = p % NE, k = 2 * (p / NE); tv[2 * q] = wsrc[k * NE + e]; tv[2 * q + 1] = wsrc[(k + 1) * NE + e]; }
#pragma unroll
        for (int q = 0; q < 16; ++q) { const int p = F.tid + NTHR * q, e = p % NE, k = 2 * (p / NE);
            const int j_ = 2 * (k >> 9) + ((k >> 2) & 1), ln_ = (k & 511) >> 3, c_ = k & 3;
            ((LAS unsigned*)wr)[e * 512 + (j_ >> 1) * 256 + ln_ * 4 + (j_ & 1) * 2 + (c_ >> 1)] = f2bf(tv[2 * q]) | (f2bf(tv[2 * q + 1]) << 16); }
    }
    __syncthreads();
    const int nrows = (l == 0) ? MT : ML;
#define N2_LOAD(row_, OPV, XV) do { const bool lat_ = (row_) < ML; \
        const bf16* opr_ = F.opb() + (size_t)(row_) * D; \
        if (L == 0) { const float* xin_ = lat_ ? F.x() + (size_t)(row_) * D : F.ctx() + (size_t)((row_) - ML) * D; \
            _Pragma("unroll") for (int jp = 0; jp < 2; ++jp) { const v4u t_ = *(const v4u*)(opr_ + 8 * F.lane + 512 * jp); OPV[2 * jp] = (v2u){t_.x, t_.y}; OPV[2 * jp + 1] = (v2u){t_.z, t_.w}; \
                XV[2 * jp] = *(const f32x4*)(xin_ + 8 * F.lane + 512 * jp); XV[2 * jp + 1] = *(const f32x4*)(xin_ + 8 * F.lane + 512 * jp + 4); } } \
        else { const bf16* xin_ = F.xb() + (size_t)(row_) * D; \
            _Pragma("unroll") for (int jp = 0; jp < 2; ++jp) { const v4u t_ = *(const v4u*)(opr_ + 8 * F.lane + 512 * jp), u_ = *(const v4u*)(xin_ + 8 * F.lane + 512 * jp); \
                OPV[2 * jp] = (v2u){t_.x, t_.y}; OPV[2 * jp + 1] = (v2u){t_.z, t_.w}; XV##b[2 * jp] = (v2u){u_.x, u_.y}; XV##b[2 * jp + 1] = (v2u){u_.z, u_.w}; } } } while (0)
    int row = ROW_OF(F, 0);
    f32x4 pG1[4], pGT[4], pG2[4], pS1[4], pSC[4];
#define N2_PARAMS(mrow_) do { const float* md_ = F.mod() + ((size_t)l * 9 + (mrow_)) * 6144; \
        _Pragma("unroll") for (int j = 0; j < 4; ++j) { const int c0 = 8 * F.lane + 512 * (j >> 1) + 4 * (j & 1); pG1[j] = *(const f32x4*)(F.g_post_mix() + l * D + c0); pGT[j] = *(const f32x4*)(md_ + 2048 + c0); \
            pG2[j] = *(const f32x4*)(F.g_pre_ffn() + l * D + c0); pS1[j] = *(const f32x4*)(md_ + 3072 + c0); pSC[j] = *(const f32x4*)(md_ + 4096 + c0); } } while (0)
    N2_PARAMS(F.bid & 7);
    v2u opn[4]; f32x4 xn[4]; v2u xnb[4];
#pragma unroll
    for (int j = 0; j < 4; ++j) { xn[j] = (f32x4){0.f, 0.f, 0.f, 0.f}; xnb[j] = (v2u){0u, 0u}; }
    N2_LOAD(row, opn, xn);
    for (int it = 0; it < 9 && row < nrows; ++it) {
        v2u opc[4]; f32x4 xc[4];
#pragma unroll
        for (int j = 0; j < 4; ++j) { opc[j] = opn[j]; xc[j] = (L == 0) ? xn[j] : (f32x4){bflo(xnb[j].x), bfhi(xnb[j].x), bflo(xnb[j].y), bfhi(xnb[j].y)}; }
        const int nrow = (it + 1 < 9) ? ROW_OF(F, it + 1) : nrows;
        if (nrow < nrows) N2_LOAD(nrow, opn, xn);
        const bool lat = row < ML;
        bf16* xr = F.xb() + (size_t)row * D;
        if (!lat) N2_PARAMS(8);
        f32x4 v[4]; float ss = 0.f;
#pragma unroll
        for (int j = 0; j < 4; ++j) { v[j] = (f32x4){bflo(opc[j].x), bfhi(opc[j].x), bflo(opc[j].y), bfhi(opc[j].y)}; ss += (v[j].x * v[j].x + v[j].y * v[j].y) + (v[j].z * v[j].z + v[j].w * v[j].w); }
        const float rstd = 1.0f / sqrtf(wave_sum(ss) * (1.f / D) + EPS);
#pragma unroll
        for (int j = 0; j < 4; ++j) v[j] = xc[j] + pGT[j] * (v[j] * rstd * pG1[j]);
#pragma unroll
        for (int jp = 0; jp < 2; ++jp) { v4u xw_; xw_.x = pk2(v[2 * jp].x, v[2 * jp].y); xw_.y = pk2(v[2 * jp].z, v[2 * jp].w); xw_.z = pk2(v[2 * jp + 1].x, v[2 * jp + 1].y); xw_.w = pk2(v[2 * jp + 1].z, v[2 * jp + 1].w);
            *(v4u*)(xr + 8 * F.lane + 512 * jp) = xw_; }
        float s2 = 0.f;
#pragma unroll
        for (int j = 0; j < 4; ++j) s2 += (v[j].x * v[j].x + v[j].y * v[j].y) + (v[j].z * v[j].z + v[j].w * v[j].w);
        const float rstd2 = 1.0f / sqrtf(wave_sum(s2) * (1.f / D) + EPS);
        float lg[NE];
#pragma unroll
        for (int e = 0; e < NE; ++e) lg[e] = 0.f;
#pragma unroll
        for (int j = 0; j < 4; ++j) v[j] = (v[j] * rstd2 * pG2[j]) * (1.0f + pSC[j]) + pS1[j];
#pragma unroll
        for (int jp = 0; jp < 2; ++jp) { const f32x4 h0_ = v[2 * jp], h1_ = v[2 * jp + 1];
            if constexpr ((FP8_GEMMS & 4) != 0) { v2u w8; w8.x = pk4_fp8(h0_.x, h0_.y, h0_.z, h0_.w, AS_H); w8.y = pk4_fp8(h1_.x, h1_.y, h1_.z, h1_.w, AS_H); *(v2u*)((unsigned char*)F.h() + (size_t)row * D + 8 * F.lane + 512 * jp) = w8; }
            else { v4u w; w.x = pk2(h0_.x, h0_.y); w.y = pk2(h0_.z, h0_.w); w.z = pk2(h1_.x, h1_.y); w.w = pk2(h1_.z, h1_.w); *(v4u*)(F.h() + (size_t)row * D + 8 * F.lane + 512 * jp) = w; } }
#define N2_DOT2(ACC, A, B) asm("v_dot2c_f32_bf16 %0, %1, %2" : "+v"(ACC) : "v"(A), "v"(B))
        unsigned hb[8];
#pragma unroll
        for (int j = 0; j < 4; ++j) { hb[2 * j] = pg8::cvt_pk_bf16(v[j].x, v[j].y); hb[2 * j + 1] = pg8::cvt_pk_bf16(v[j].z, v[j].w); }
#pragma unroll
        for (int e = 0; e < NE; ++e) {
            const v4u q0 = *(const LAS v4u*)((const LAS unsigned char*)wr + e * 2048 + F.lane * 16), q1 = *(const LAS v4u*)((const LAS unsigned char*)wr + e * 2048 + 1024 + F.lane * 16);
            float a_ = 0.f;
            N2_DOT2(a_, hb[0], q0.x); N2_DOT2(a_, hb[1], q0.y);
            N2_DOT2(a_, hb[2], q0.z); N2_DOT2(a_, hb[3], q0.w);
            N2_DOT2(a_, hb[4], q1.x); N2_DOT2(a_, hb[5], q1.y);
            N2_DOT2(a_, hb[6], q1.z); N2_DOT2(a_, hb[7], q1.w);
            lg[e] = a_;
            if ((e & 7) == 7) asm volatile("" ::: "memory"); }
        float r4[4];
        const int bix_ = (F.lane ^ 16) << 2;
        {
            float r8[8];
#pragma unroll
            for (int e = 0; e < 8; ++e) { const bool lo_ = F.lane < 32; const float keep_ = lo_ ? lg[e] : lg[e + 8], send_ = lo_ ? lg[e + 8] : lg[e];
                r8[e] = keep_ + __builtin_bit_cast(float, __builtin_amdgcn_ds_bpermute(bix_ ^ (48 << 2), __builtin_bit_cast(int, send_))); }
#pragma unroll
            for (int e = 0; e < 4; ++e) { const bool ev_ = ((F.lane >> 4) & 1) == 0; const float keep_ = ev_ ? r8[e] : r8[e + 4], send_ = ev_ ? r8[e + 4] : r8[e];
                r4[e] = keep_ + __builtin_bit_cast(float, __builtin_amdgcn_ds_bpermute(bix_, __builtin_bit_cast(int, send_))); }
#pragma unroll
            for (int e = 0; e < 4; ++e) { float v_ = r4[e]; v_ = DPP_ADD(v_, 0x128, 0xF); v_ = DPP_ADD(v_, 0x124, 0xF); v_ = DPP_ADD(v_, 0x122, 0xF); v_ = DPP_ADD(v_, 0x121, 0xF); r4[e] = v_; }
        }
        float mx = fmaxf(fmaxf(r4[0], r4[1]), fmaxf(r4[2], r4[3]));
        mx = fmaxf(mx, __builtin_bit_cast(float, __builtin_amdgcn_ds_bpermute(bix_, __builtin_bit_cast(int, mx))));
        mx = fmaxf(mx, __builtin_bit_cast(float, __builtin_amdgcn_ds_bpermute(bix_ ^ (48 << 2), __builtin_bit_cast(int, mx))));
        float se = 0.f;
#pragma unroll
        for (int e = 0; e < 4; ++e) { r4[e] = expf(r4[e] - mx); se += r4[e]; }
        se += __builtin_bit_cast(float, __builtin_amdgcn_ds_bpermute(bix_, __builtin_bit_cast(int, se)));
        se += __builtin_bit_cast(float, __builtin_amdgcn_ds_bpermute(bix_ ^ (48 << 2), __builtin_bit_cast(int, se)));
        const int li = F.lane & 15, eid = (li & 3) + 4 * ((F.lane >> 4) & 1) + 8 * (F.lane >> 5);
        const float mine = (li == 0) ? r4[0] : (li == 1) ? r4[1] : (li == 2) ? r4[2] : r4[3];
        if (li < 4) {
            if (lat) F.affT()[((size_t)(row / SEQ) * NE + eid) * SEQ + (row % SEQ)] = mine / se;
            else { const int rc = row - ML; F.affcT()[((size_t)(rc / LC) * NE + eid) * LC + (rc % LC)] = mine / se; }
        }
        row = nrow;
    }
#undef N2_LOAD
#undef N2_PARAMS
}

__device__ __forceinline__ void topk_item(Frame& F, const float* vals, int n, int cap, int* slot_tab  , float* gate  , int* rowidx  , int row_base) {
    LAS int* cnt = (LAS int*)F.lds;
    const int tid = F.tid, lane = F.lane, wave = F.wave;
    unsigned k[4] = {0u, 0u, 0u, 0u};
    if (4 * tid < n) { const v4u v = *(const v4u*)(vals + 4 * tid); k[0] = v.x; k[1] = v.y; k[2] = v.z; k[3] = v.w; }
    __syncthreads();
    unsigned T = 0u; int buf = 0;
    for (int bit = 29; bit >= 1; bit -= 2) {
        const unsigned c1 = T | (1u << bit), c2 = T | (2u << bit), c3 = T | (3u << bit);
        const int n1 = __popcll(__ballot(k[0] >= c1)) + __popcll(__ballot(k[1] >= c1)) + __popcll(__ballot(k[2] >= c1)) + __popcll(__ballot(k[3] >= c1));
        const int n2 = __popcll(__ballot(k[0] >= c2)) + __popcll(__ballot(k[1] >= c2)) + __popcll(__ballot(k[2] >= c2)) + __popcll(__ballot(k[3] >= c2));
        const int n3 = __popcll(__ballot(k[0] >= c3)) + __popcll(__ballot(k[1] >= c3)) + __popcll(__ballot(k[2] >= c3)) + __popcll(__ballot(k[3] >= c3));
        if (lane == 0) { cnt[buf * 24 + wave] = n1; cnt[buf * 24 + 8 + wave] = n2; cnt[buf * 24 + 16 + wave] = n3; }
        __syncthreads();
        int t1 = 0, t2 = 0, t3 = 0;
#pragma unroll
        for (int w = 0; w < 8; ++w) { t1 += cnt[buf * 24 + w]; t2 += cnt[buf * 24 + 8 + w]; t3 += cnt[buf * 24 + 16 + w]; }
        T = (t3 >= cap) ? c3 : (t2 >= cap) ? c2 : (t1 >= cap) ? c1 : T;
        buf ^= 1;
    }
    {   const unsigned cand = T | 1u;
        const int c = __popcll(__ballot(k[0] >= cand)) + __popcll(__ballot(k[1] >= cand)) + __popcll(__ballot(k[2] >= cand)) + __popcll(__ballot(k[3] >= cand));
        if (lane == 0) cnt[buf * 24 + wave] = c;
        __syncthreads();
        int tot = 0;
#pragma unroll
        for (int w = 0; w < 8; ++w) tot += cnt[buf * 24 + w];
        if (tot >= cap) T = cand;
        buf ^= 1;
    }
    int g[4], q[4], pk = 0;
#pragma unroll
    for (int i = 0; i < 4; ++i) { g[i] = k[i] > T ? 1 : 0; q[i] = k[i] == T ? 1 : 0; pk += (g[i] << 16) | q[i]; }
    int inc = pk;
#pragma unroll
    for (int o = 1; o < 64; o <<= 1) { const int v = __shfl_up(inc, o); if (lane >= o) inc += v; }
    if (lane == 63) cnt[64 + wave] = inc;
    __syncthreads();
    int carry = 0, total = 0;
#pragma unroll
    for (int w = 0; w < 8; ++w) { const int v = cnt[64 + w]; if (w < wave) carry += v; total += v; }
    int before = carry + inc - pk;
    const int need_eq = cap - (total >> 16);
    int gb = before >> 16, eb = before & 0xffff;
#pragma unroll
    for (int i = 0; i < 4; ++i) {
        int sl = -1;
        if (g[i]) sl = gb + (eb < need_eq ? eb : need_eq);
        else if (q[i] && eb < need_eq) sl = gb + eb;
        const int tok = 4 * tid + i;
        if (tok < n) {
            slot_tab[tok] = sl;
            if (sl >= 0) { rowidx[sl] = row_base + tok; gate[sl] = __builtin_bit_cast(float, k[i]); }
        }
        gb += g[i]; eb += q[i];
    }
    __syncthreads();
}
__device__ __forceinline__ void ph_topk(Frame& F, int l) {
    const int nitems = 128 + (l == 0 ? 128 : 0);
    for (int it = F.bid; it < nitems; it += F.G) {
        if (it < 128) { const int b = it & 7, e = it >> 3, be = b * NE + e; const size_t r0 = (size_t)e * ER + b * CAP;
            topk_item(F, F.affT() + (size_t)be * SEQ, SEQ, CAP, F.slot() + (size_t)be * SEQ, F.gate() + r0, F.rowidx() + r0, b * SEQ); }
        else { const int b = it & 7, e = (it - 128) >> 3, be = b * NE + e; const size_t r0 = (size_t)e * ER + NB * CAP + b * CAPC;
            topk_item(F, F.affcT() + (size_t)be * LC, LC, CAPC, F.slotc() + (size_t)be * LC, F.gate() + r0, F.rowidx() + r0, ML + b * LC); }
    }
}

template <int L>
__device__ __forceinline__ void ph_n3(Frame& F) {
    constexpr int l = L;
    const int nrows = (l == 0) ? MT : ML;
#define N3_LOAD(row_, SL, XV) do { const bool lat_ = (row_) < ML; const int rc_ = (row_) - ML; \
        const bf16* xr_ = F.xb() + (size_t)(row_) * D; \
        SL = lat_ ? F.slot()[((size_t)((row_) / SEQ) * NE + (F.lane & 15)) * SEQ + ((row_) % SEQ)] : F.slotc()[((size_t)(rc_ / LC) * NE + (F.lane & 15)) * LC + (rc_ % LC)]; \
        _Pragma("unroll") for (int jp = 0; jp < 2; ++jp) { const v4u t_ = *(const v4u*)(xr_ + 8 * F.lane + 512 * jp); XV[2 * jp] = (v2u){t_.x, t_.y}; XV[2 * jp + 1] = (v2u){t_.z, t_.w}; } } while (0)
    int row = ROW_OF(F, 0);
    int slA = -1, slB = -1; v2u xA[4], xB[4];
#pragma unroll
    for (int j = 0; j < 4; ++j) { xA[j] = (v2u){0u, 0u}; xB[j] = (v2u){0u, 0u}; }
    const int row1 = ROW_OF(F, 1);
    {
        LAS float* pl = (LAS float*)F.lds;
        float tv[20];
#pragma unroll
        for (int q = 0; q < 20; ++q) { const int i = F.tid + NTHR * q, set = i / (5 * D), a = (i / D) % 5, c = i % D; const int mrow_ = set ? 8 : (F.bid & 7);
            const float* md_ = F.mod() + ((size_t)l * 9 + mrow_) * 6144; const float* md2_ = F.mod() + ((size_t)(L + 1 < DEPTH ? l + 1 : l) * 9 + mrow_) * 6144;
            tv[q] = a == 0 ? F.g_post_ffn()[l * D + c] : a == 1 ? md_[5120 + c] : a == 2 ? F.g_pre_mix()[(L + 1 < DEPTH ? l + 1 : l) * D + c] : a == 3 ? md2_[c] : md2_[1024 + c]; }
        N3_LOAD(row, slB, xB);
        if (row1 < nrows) N3_LOAD(row1, slA, xA);
#pragma unroll
        for (int q = 0; q < 20; ++q) { const int i = F.tid + NTHR * q, c = i % D; pl[i - c + (2 * (c >> 9) + ((c >> 2) & 1)) * 256 + 4 * ((c & 511) >> 3) + (c & 3)] = tv[q]; }
        __syncthreads();
    }
#define N3_P(set, a, j) (*(const LAS f32x4*)((const LAS float*)F.lds + ((set) * 5 + (a)) * D + 4 * F.lane + 256 * (j)))
#define N3_RBASE(row_) ((row_) < ML ? ((row_) / SEQ) * CAP : NB * CAP + (((row_) - ML) / LC) * CAPC)
#define N3_YLOAD(row_, SL, G0, G1, W0, W1, REST) do { unsigned m_ = (unsigned)(__ballot((SL) >= 0) & 0xFFFFull); const int rb_ = N3_RBASE(row_); \
        const bool h0_ = m_ != 0u; const int e0_ = h0_ ? __builtin_ctz(m_) : 0; if (h0_) m_ &= m_ - 1u; \
        const bool h1_ = m_ != 0u; const int e1_ = h1_ ? __builtin_ctz(m_) : 0; if (h1_) m_ &= m_ - 1u; REST = m_; \
        const size_t er0_ = h0_ ? (size_t)e0_ * ER + rb_ + __shfl((SL), e0_) : (size_t)0, er1_ = h1_ ? (size_t)e1_ * ER + rb_ + __shfl((SL), e1_) : er0_; \
        G0 = h0_ ? F.gate()[er0_] : 0.f; G1 = h1_ ? F.gate()[er1_] : 0.f; \
        _Pragma("unroll") for (int jp = 0; jp < 2; ++jp) { const v4u t0_ = *(const v4u*)(F.Y() + er0_ * D + 8 * F.lane + 512 * jp), t1_ = *(const v4u*)(F.Y() + er1_ * D + 8 * F.lane + 512 * jp); \
            W0[2 * jp] = (v2u){t0_.x, t0_.y}; W0[2 * jp + 1] = (v2u){t0_.z, t0_.w}; W1[2 * jp] = (v2u){t1_.x, t1_.y}; W1[2 * jp + 1] = (v2u){t1_.z, t1_.w}; } } while (0)
    float g0B = 0.f, g1B = 0.f; v2u w0B[4], w1B[4]; unsigned restB = 0u;
#pragma unroll
    for (int j = 0; j < 4; ++j) { w0B[j] = (v2u){0u, 0u}; w1B[j] = (v2u){0u, 0u}; }
    N3_YLOAD(row, slB, g0B, g1B, w0B, w1B, restB);
#pragma unroll 1
    for (int it = 0; it < 9 && row < nrows; ++it) {
        const int sl = slB; v2u xc[4], w0[4], w1[4]; const float g0 = g0B, g1 = g1B; unsigned msk = restB;
#pragma unroll
        for (int j = 0; j < 4; ++j) { xc[j] = xB[j]; w0[j] = w0B[j]; w1[j] = w1B[j]; }
        const int nrow = (it + 1 < 9) ? ROW_OF(F, it + 1) : nrows, nnrow = (it + 2 < 9) ? ROW_OF(F, it + 2) : nrows;
        slB = slA;
#pragma unroll
        for (int j = 0; j < 4; ++j) xB[j] = xA[j];
        if (nrow < nrows) N3_YLOAD(nrow, slB, g0B, g1B, w0B, w1B, restB);
        if (nnrow < nrows) N3_LOAD(nnrow, slA, xA);
        const bool lat = row < ML; const int pset = lat ? 0 : 1;
        const int rbase = N3_RBASE(row);
        f32x4 y[4];
#pragma unroll
        for (int j = 0; j < 4; ++j) {
            y[j].x = g0 * bflo(w0[j].x) + g1 * bflo(w1[j].x); y[j].y = g0 * bfhi(w0[j].x) + g1 * bfhi(w1[j].x);
            y[j].z = g0 * bflo(w0[j].y) + g1 * bflo(w1[j].y); y[j].w = g0 * bfhi(w0[j].y) + g1 * bfhi(w1[j].y); }
        while (msk) {
            const int e0 = __builtin_ctz(msk); msk &= msk - 1u;
            const int e1 = msk ? __builtin_ctz(msk) : -1; if (e1 >= 0) msk &= msk - 1u;
            const size_t er0 = (size_t)e0 * ER + rbase + __shfl(sl, e0);
            const size_t er1 = e1 >= 0 ? (size_t)e1 * ER + rbase + __shfl(sl, e1) : er0;
            const float h0 = F.gate()[er0], h1 = e1 >= 0 ? F.gate()[er1] : 0.f;
            v2u u0[4], u1[4];
#pragma unroll
            for (int jp = 0; jp < 2; ++jp) { const v4u t0_ = *(const v4u*)(F.Y() + er0 * D + 8 * F.lane + 512 * jp), t1_ = *(const v4u*)(F.Y() + er1 * D + 8 * F.lane + 512 * jp);
                u0[2 * jp] = (v2u){t0_.x, t0_.y}; u0[2 * jp + 1] = (v2u){t0_.z, t0_.w}; u1[2 * jp] = (v2u){t1_.x, t1_.y}; u1[2 * jp + 1] = (v2u){t1_.z, t1_.w}; }
#pragma unroll
            for (int j = 0; j < 4; ++j) {
                y[j].x += h0 * bflo(u0[j].x) + h1 * bflo(u1[j].x); y[j].y += h0 * bfhi(u0[j].x) + h1 * bfhi(u1[j].x);
                y[j].z += h0 * bflo(u0[j].y) + h1 * bflo(u1[j].y); y[j].w += h0 * bfhi(u0[j].y) + h1 * bfhi(u1[j].y); }
        }
        float ss = 0.f;
#pragma unroll
        for (int j = 0; j < 4; ++j) ss += (y[j].x * y[j].x + y[j].y * y[j].y) + (y[j].z * y[j].z + y[j].w * y[j].w);
        const float rstd = 1.0f / sqrtf(wave_sum(ss) * (1.f / D) + EPS);
        f32x4 v[4];
#pragma unroll
        for (int j = 0; j < 4; ++j) { const int c0 = 8 * F.lane + 512 * (j >> 1) + 4 * (j & 1);
            v[j] = (f32x4){bflo(xc[j].x), bfhi(xc[j].x), bflo(xc[j].y), bfhi(xc[j].y)} + N3_P(pset, 1, j) * (y[j] * rstd * N3_P(pset, 0, j));
            if (L + 1 >= DEPTH) *(f32x4*)(F.out() + (size_t)row * D + c0) = v[j]; }
        if (L + 1 < DEPTH) {
#pragma unroll
            for (int jp = 0; jp < 2; ++jp) { v4u xw_; xw_.x = pk2(v[2 * jp].x, v[2 * jp].y); xw_.y = pk2(v[2 * jp].z, v[2 * jp].w); xw_.z = pk2(v[2 * jp + 1].x, v[2 * jp + 1].y); xw_.w = pk2(v[2 * jp + 1].z, v[2 * jp + 1].w);
                *(v4u*)(F.xb() + (size_t)row * D + 8 * F.lane + 512 * jp) = xw_; } }
        if (L + 1 < DEPTH) {
            float s2 = 0.f;
#pragma unroll
            for (int j = 0; j < 4; ++j) s2 += (v[j].x * v[j].x + v[j].y * v[j].y) + (v[j].z * v[j].z + v[j].w * v[j].w);
            const float rstd2 = 1.0f / sqrtf(wave_sum(s2) * (1.f / D) + EPS);
#pragma unroll
            for (int jp = 0; jp < 2; ++jp) { const f32x4 o0 = (v[2 * jp] * rstd2 * N3_P(pset, 2, 2 * jp)) * (1.0f + N3_P(pset, 4, 2 * jp)) + N3_P(pset, 3, 2 * jp);
                const f32x4 o1 = (v[2 * jp + 1] * rstd2 * N3_P(pset, 2, 2 * jp + 1)) * (1.0f + N3_P(pset, 4, 2 * jp + 1)) + N3_P(pset, 3, 2 * jp + 1);
                if constexpr ((FP8_GEMMS & 1) != 0) { v2u w8; w8.x = pk4_fp8(o0.x, o0.y, o0.z, o0.w, AS_H); w8.y = pk4_fp8(o1.x, o1.y, o1.z, o1.w, AS_H); *(v2u*)((unsigned char*)F.h() + (size_t)row * D + 8 * F.lane + 512 * jp) = w8; }
                else { v4u w; w.x = pk2(o0.x, o0.y); w.y = pk2(o0.z, o0.w); w.z = pk2(o1.x, o1.y); w.w = pk2(o1.z, o1.w);
                *(v4u*)(F.h() + (size_t)row * D + 8 * F.lane + 512 * jp) = w; } }
        }
        row = nrow;
    }
#undef N3_YLOAD
#undef N3_RBASE
#undef N3_LOAD
#undef N3_P
}

constexpr int NPHASE = 2 + 9 * DEPTH;

__global__ void __launch_bounds__(NTHR, 2) fwd_kernel(Args args) {
    extern __shared__ __attribute__((aligned(16))) unsigned char lds[];
    Frame F;
    F.lds = (LAS unsigned char*)lds;
    F.tid = threadIdx.x; F.lane = F.tid & 63; F.wave = __builtin_amdgcn_readfirstlane(F.tid >> 6);
    F.G = gridDim.x; F.bid = blockIdx.x;
    unsigned char* ws = args.ws;
    for (int u = F.tid; u < (LDS_BYTES - LDSCTL_OFF) / 4; u += NTHR) ((LAS unsigned*)(F.lds + LDSCTL_OFF))[u] = 0u;
    __syncthreads();
    volatile LAS unsigned* MISC = (volatile LAS unsigned*)(F.lds + MISC_OFF);
    XcdBarrier bar; bar.bar = (unsigned*)(ws + WS_CTL) + 4096; bar.x = 0; bar.st = nullptr;
    const int lo = args.ph_lo, hi = args.ph_hi;
    if (hi - lo > 1) bar = xcd_barrier_post((unsigned*)(ws + WS_CTL) + 4096, MISC + 8);
    if (hi - lo > 1 && threadIdx.x == 0) { const unsigned x_ = xb_xcc_id(); MISC[12] = xb_add((unsigned*)(ws + WS_CTL) + 8192 + 64 * x_, 1u); MISC[13] = x_; }

#ifndef PHSEL
#define PHSEL(k) true
#endif
#ifndef REP_PRO
#define REP_PRO 1
#define REP_QKV 1
#define REP_ATT 1
#define REP_OUT 1
#define REP_TOPK 1
#define REP_GU 1
#define REP_DN 1
#endif
    for (int ph = lo; ph < hi; ++ph) {
        { const CAS Args* kp = (const CAS Args*)__builtin_amdgcn_kernarg_segment_ptr(); asm volatile("" : "+s"(kp)); F.ka = kp;
          int t_ = threadIdx.x, b_ = (MISC[14] != 0u) ? (int)(MISC[13] + 8u * MISC[12]) : (int)blockIdx.x, g_ = gridDim.x; b_ = __builtin_amdgcn_readfirstlane(b_); asm volatile("" : "+v"(t_), "+s"(b_), "+s"(g_));
          F.tid = t_; F.lane = t_ & 63; F.wave = __builtin_amdgcn_readfirstlane(t_ >> 6); F.bid = b_; F.G = g_; }
        if (ph == 0) { if (PHSEL(100)) for (int rep = 0; rep < REP_PRO; ++rep) { ph_prologue(F); __syncthreads(); } }
        else if (ph == 1) { if (PHSEL(101)) ph_norm1(F, 0); }
        else {
            const int l = (ph - 2) / 9, s = (ph - 2) % 9;
            if (PHSEL(s)) switch (s) {
#if NAIVE_GEMM
            case 0: { EpiNBf16 E{F.p(), PROJ}; gemm_naive(F, F.h(), F.win_t() + (size_t)l * PROJ * D, MT, PROJ, 0, 0, 0, E); } break;
            case 1: ph_prep(F, l); break;
            case 2: ph_attn_naive(F, l); break;
            case 3: { EpiNF32 E{F.op(), D}; gemm_naive(F, F.o(), F.wout_t() + (size_t)l * D * D, l == 0 ? MT : ML, D, 0, 0, 0, E); } break;
            case 4: if (l == 0) ph_n2<0>(F); else ph_n2<1>(F); break;
            case 5: ph_topk(F, l); break;
            case 6: { EpiNGateUp E{F.act()}; gemm_naive(F, F.xe(), F.wgu_t() + (size_t)l * NE * 2048 * D, NE * ER, 2048, ER, (size_t)2048 * D, l == 0 ? ER : NB * CAP, E); } break;
            case 7: { EpiNBf16 E{F.Y(), D}; gemm_naive(F, F.act(), F.wdn_t() + (size_t)l * NE * D * D, NE * ER, D, ER, (size_t)D * D, l == 0 ? ER : NB * CAP, E); } break;
#else
            case 0: for (int rep = 0; rep < REP_QKV; ++rep) { constexpr bool F8 = (FP8_GEMMS & 1) != 0;
                      pg8::Gemm g{F.h(), F.win_t() + (size_t)l * PROJ * D, MT, PROJ, F8 ? D / 2 : D, 0, 0, nullptr, F8 ? 1.f / (AS_H * WS8) : 1.f}; pg8::BatchOrder S; S.init(MT, PROJ, F.bid);
                      pg8::EpiQKV E{F.p(), F.cosA(), F.sinA(), F.cosB(), F.sinB(), F.q_gain_a() + l * 64, F.k_gain_a() + l * 64, ML, SEQ, PROJ}; pg8::gemm_phase<pg8::EpiQKV, pg8::BatchOrder, true, true, false, F8>(F.lds, g, S, E); } break;
            case 1: break;
#if NAIVE_ATTN
            case 2: ph_attn_naive(F, l); break;
#else
            case 2: for (int rep = 0; rep < REP_ATT; ++rep) ph_attn(F, l); break;
#endif
            case 3: for (int rep = 0; rep < REP_OUT; ++rep) { const int M = (l == 0) ? MT : ML; constexpr bool F8 = (FP8_GEMMS & 2) != 0;
                      pg8::Gemm g{F.o(), F.wout_t() + (size_t)l * D * D, M, D, F8 ? D / 2 : D, 0, 0, nullptr, F8 ? 1.f / (AS_O * WS8) : 1.f}; pg8::BatchOrder S; S.init(M, D, F.bid);
                      pg8::EpiBf16 E{F.opb(), D}; pg8::gemm_phase<pg8::EpiBf16, pg8::BatchOrder, true, true, false, F8>(F.lds, g, S, E); } break;
            case 4: if (l == 0) ph_n2<0>(F); else ph_n2<1>(F); break;
            case 5: for (int rep = 0; rep < REP_TOPK; ++rep) ph_topk(F, l); break;
            case 6: for (int rep = 0; rep < REP_GU; ++rep) { constexpr bool F8 = (FP8_GEMMS & 4) != 0, O8 = (FP8_GEMMS & 8) != 0;
                      pg8::Gemm g{F.h(), F.wgu_t() + (size_t)l * NE * 2048 * D, NE * ER, 2048, F8 ? D / 2 : D, ER / 256, (size_t)2048 * D * 2, F.rowidx(), F8 ? 1.f / (AS_H * WS8) : 1.f}; pg8::GroupedOrder S; S.init(NE, ER / 256, l == 0 ? 9 : 8, 8, F.G, F.bid); S.pn_fast = true;
                      pg8::EpiGateUpT<O8> E{F.act(), D}; pg8::gemm_phase<pg8::EpiGateUpT<O8>, pg8::GroupedOrder, true, true, true, F8>(F.lds, g, S, E); } break;
            case 7: for (int rep = 0; rep < REP_DN; ++rep) { constexpr bool F8 = (FP8_GEMMS & 8) != 0;
                      pg8::Gemm g{F.act(), F.wdn_t() + (size_t)l * NE * D * D, NE * ER, D, F8 ? D / 2 : D, ER / 256, (size_t)D * D * 2, nullptr, F8 ? 1.f / (AS_ACT * WS8) : 1.f}; pg8::GroupedOrder S; S.init(NE, ER / 256, l == 0 ? 9 : 8, 4, F.G, F.bid);
                      pg8::EpiBf16 E{F.Y(), D}; pg8::gemm_phase<pg8::EpiBf16, pg8::GroupedOrder, true, true, false, F8>(F.lds, g, S, E); } break;
#endif
            case 8: if (l == 0) ph_n3<0>(F); else ph_n3<1>(F); break;
            }
        }
        {
            int cb = 0, ce = 0, cs = 0, cst = 1;
            if (ph == 0) { cb = 0; ce = CVT_ATT ? CVT_N_IN + CVT_N_OUT : CVT_N0; cs = F.bid * NWAVES + F.wave; cst = F.G * NWAVES; }
            else if (ph == 2 + 0 && (F.bid >> 3) >= 26) {
                cb = CVT_N0; ce = CVT_A; cs = ((F.bid & 7) * 6 + (F.bid >> 3) - 26) * NWAVES + F.wave; cst = CVT_W_QKV; }
            else if (ph == 2 + 3 && (F.bid >> 3) >= 4) {
                cb = CVT_A; ce = CVT_B; cs = ((F.bid & 7) * 28 + (F.bid >> 3) - 4) * NWAVES + F.wave; cst = CVT_W_OUT; }
            else if (ph == 2 + 6 && F.bid >= 128) {
                cb = CVT_B; ce = CVT_C; cs = (F.bid - 128) * NWAVES + F.wave; cst = CVT_W_GU; }
            else if (ph == 2 + 7 && F.bid >= 64) {
                cb = CVT_C; ce = CVT_NT; cs = (F.bid - 64) * NWAVES + F.wave; cst = CVT_W_DN; }
            if (ce > cb) { __syncthreads(); convert_items(F, cb, ce, cs, cst); }
        }
        if (ph + 1 < hi && !(ph >= 2 && (ph - 2) % 9 == 1)) {
            const bool need_grid = (MISC[14] == 0u) || ph == 0 || (ph >= 2 && ((ph - 2) % 9 == 5 || (ph - 2) % 9 == 7 || (ph - 2) % 9 == 8));
            __syncthreads(); xcd_barrier(bar, need_grid);
            if (ph == 0) {
                if (threadIdx.x == 0) { bool ok = (gridDim.x == 256);
                    unsigned cn_[16];
#pragma unroll
                    for (int j = 0; j < 16; ++j) cn_[j] = xb_ld((unsigned*)(ws + WS_CTL) + 4096 + XB_XCNT(j));
#pragma unroll
                    for (int j = 0; j < 16; ++j) ok = ok & (cn_[j] == (j < 8 ? 32u : 0u));
                    MISC[14] = ok ? 1u : 0u; }
                __syncthreads();
            }
        }
    }
}

extern "C" void kernel_launch(void* const* d_in, const int* in_sizes, int n_in, void* d_out, int out_size, void* d_ws, size_t ws_size, hipStream_t stream) {
    static int grid = 0;
    if (grid == 0) {
        if (n_in != 25 || out_size != ML * D || ws_size < WS_END) { fprintf(stderr, "kernel_launch: unexpected shapes (n_in %d, out %d, ws %zu)\n", n_in, out_size, ws_size); grid = -1; return; }
        int dev = 0, cus = 0;
        if (hipGetDevice(&dev) != hipSuccess || hipDeviceGetAttribute(&cus, hipDeviceAttributeMultiprocessorCount, dev) != hipSuccess) { grid = -1; return; }
        if (hipFuncSetAttribute((const void*)fwd_kernel, hipFuncAttributeMaxDynamicSharedMemorySize, LDS_BYTES) != hipSuccess) { fprintf(stderr, "kernel_launch: hipFuncSetAttribute failed\n"); grid = -1; return; }
        (void)hipGetLastError();
        grid = cus;
        if (grid != 256) { fprintf(stderr, "kernel_launch: built for a 256-CU device (got %d)\n", cus); grid = -1; return; }
    }
    if (grid < 0) return;
    (void)hipMemsetAsync((char*)d_ws + WS_CTL, 0, CTL_ZERO_BYTES, stream);
    Args a{};
    for (int i = 0; i < 25; ++i) a.in[i] = (const float*)d_in[i];
    a.out = (float*)d_out; a.ws = (unsigned char*)d_ws;
#if MK_ONE_LAUNCH
    a.ph_lo = 0; a.ph_hi = NPHASE;
    hipLaunchKernelGGL(fwd_kernel, dim3(grid), dim3(NTHR), LDS_BYTES, stream, a);
#else
    for (int ph = 0; ph < NPHASE; ++ph) { a.ph_lo = ph; a.ph_hi = ph + 1; hipLaunchKernelGGL(fwd_kernel, dim3(grid), dim3(NTHR), LDS_BYTES, stream, a); }
#endif
}
```
